# Optimizing an MI355X kernel written in HIP

```python
import jax, jax.numpy as jnp
from jax import lax
import numpy as np

D_MODEL = 1024
BATCH = 8
SEQ = 2048
DEPTH = 1
DEC_BATCH = 128
DEC_SEQ = 4
PAST_LEN = 16384
PAGE_SIZE = 128

CHUNK = 128
H_A = 8
W_A = D_MODEL
DH_A = W_A // H_A
H_B = 8
W_B = D_MODEL
CONV_W = 3
P_DIM = 256
EPS = 1e-6
LN_EPS = 1e-5
SPLIT_WIDTHS = [W_A, W_A, W_A, W_B, W_B, W_B, W_B, D_MODEL, D_MODEL]
SPLIT_IDX = [int(i) for i in np.cumsum(SPLIT_WIDTHS)[:-1]]
IN_COLS = int(sum(SPLIT_WIDTHS))

kernel_name = "gated_parallel_gmlp_shortconv_decoder_step"


def rms_norm(x, g):
    xf = x.astype(jnp.float32)
    y = xf * lax.rsqrt(jnp.mean(xf * xf, axis=-1, keepdims=True) + EPS)
    return (y * g.astype(jnp.float32)).astype(x.dtype)


def layer_norm(x, g, b):
    xf = x.astype(jnp.float32)
    mu = jnp.mean(xf, axis=-1, keepdims=True)
    var = jnp.mean(jnp.square(xf - mu), axis=-1, keepdims=True)
    y = (xf - mu) * lax.rsqrt(var + LN_EPS)
    return (y * g.astype(jnp.float32) + b.astype(jnp.float32)).astype(x.dtype)


def chunk_spatial_mix(v, w_s, b_s):
    bsz, L, _ = v.shape
    n = -(-L // CHUNK)
    pad = n * CHUNK - L
    vp = jnp.pad(v, ((0, 0), (0, pad), (0, 0))).reshape(bsz, n, CHUNK, H_A, DH_A)
    mask = jnp.tril(jnp.ones((CHUNK, CHUNK), dtype=bool))
    w = jnp.where(mask[None], w_s, jnp.zeros_like(w_s))
    s = jnp.einsum('hts,bnshd->bnthd', w, vp) + jnp.transpose(b_s)[None, None, :, :, None]
    return s.reshape(bsz, n * CHUNK, W_A)[:, :L]


def causal_conv(u, state, conv_w):
    L = u.shape[1]
    full = jnp.concatenate([state.astype(u.dtype), u], axis=1)
    y = conv_w[0] * full[:, 0:L]
    for k in range(1, CONV_W):
        y = y + conv_w[k] * full[:, k:k + L]
    return y, full[:, -(CONV_W - 1):]


def mixer_layer(x, p, conv_state, norm_g, w_in, ln_v_g, ln_v_b, w_s, b_s, conv_w,
                w_a_out, w_b_out, w_o, pe_norm_g, w_pe_gate, w_pe_proj):
    h = rms_norm(x, norm_g)
    z = jnp.einsum('bld,de->ble', h, w_in)
    u_a, v_a, gate_a, c_b, b_b, h_b, gate_b, m_a, m_b = jnp.split(z, SPLIT_IDX, axis=-1)
    u_a = jax.nn.gelu(u_a)
    v_a = layer_norm(jax.nn.gelu(v_a), ln_v_g, ln_v_b)
    s = chunk_spatial_mix(v_a, w_s, b_s)
    y_a = u_a * s * jax.nn.silu(gate_a)
    conv_out, new_conv = causal_conv(c_b * h_b, conv_state, conv_w)
    y_b = b_b * conv_out * jax.nn.silu(gate_b)
    merged = (jax.nn.sigmoid(m_a) * jnp.einsum('blw,wd->bld', y_a, w_a_out)
              + jax.nn.sigmoid(m_b) * jnp.einsum('blw,wd->bld', y_b, w_b_out))
    x = x + jnp.einsum('bld,de->ble', merged, w_o)
    pe_gate = jax.nn.sigmoid(jnp.einsum('bld,de->ble', rms_norm(x, pe_norm_g), w_pe_gate))
    x = x + pe_gate * jnp.einsum('blp,pd->bld', p, w_pe_proj)
    L = v_a.shape[1]
    start = ((L - 1) // CHUNK) * CHUNK
    return x, new_conv, v_a[:, start:]


def setup_inputs(seed: int = 0) -> dict:
    key = jax.random.key(seed)
    ks = jax.random.split(key, 20)
    f32 = jnp.float32
    nrm = lambda k, shape, scale: jax.random.normal(k, shape, f32) * scale
    return {
        "x_prompt": nrm(ks[0], (BATCH, SEQ, D_MODEL), 1.0),
        "x_sample": nrm(ks[1], (DEC_BATCH, DEC_SEQ, D_MODEL), 1.0),
        "state_conv": nrm(ks[2], (DEPTH, DEC_BATCH, CONV_W - 1, W_B), 0.5),
        "p_prompt": nrm(ks[3], (DEPTH, BATCH, SEQ, P_DIM), 1.0),
        "p_sample": nrm(ks[4], (DEPTH, DEC_BATCH, DEC_SEQ, P_DIM), 1.0),
        "norm_g": 1.0 + nrm(ks[5], (DEPTH, D_MODEL), 0.1),
        "w_in": nrm(ks[6], (DEPTH, D_MODEL, IN_COLS), D_MODEL ** -0.5),
        "ln_v_g": 1.0 + nrm(ks[7], (DEPTH, W_A), 0.1),
        "ln_v_b": nrm(ks[8], (DEPTH, W_A), 0.02),
        "w_s": nrm(ks[9], (DEPTH, H_A, CHUNK, CHUNK), 0.5 * CHUNK ** -0.5),
        "b_s": 1.0 + nrm(ks[10], (DEPTH, H_A, CHUNK), 0.1),
        "conv_w": nrm(ks[11], (DEPTH, CONV_W, W_B), CONV_W ** -0.5),
        "w_a_out": nrm(ks[12], (DEPTH, W_A, D_MODEL), W_A ** -0.5),
        "w_b_out": nrm(ks[13], (DEPTH, W_B, D_MODEL), W_B ** -0.5),
        "w_o": nrm(ks[14], (DEPTH, D_MODEL, D_MODEL), D_MODEL ** -0.5),
        "pe_norm_g": 1.0 + nrm(ks[15], (DEPTH, D_MODEL), 0.1),
        "w_pe_gate": nrm(ks[16], (DEPTH, D_MODEL, D_MODEL), D_MODEL ** -0.5),
        "w_pe_proj": nrm(ks[17], (DEPTH, P_DIM, D_MODEL), P_DIM ** -0.5),
        "final_norm_g": 1.0 + nrm(ks[18], (D_MODEL,), 0.1),
    }


def reference(x_prompt, x_sample, state_conv, p_prompt, p_sample, norm_g, w_in, ln_v_g,
              ln_v_b, w_s, b_s, conv_w, w_a_out, w_b_out, w_o, pe_norm_g, w_pe_gate,
              w_pe_proj, final_norm_g):
    xp, xs = x_prompt, x_sample
    conv_p_list, conv_s_list, v_p_list, v_s_list = [], [], [], []
    zero_state = jnp.zeros((x_prompt.shape[0], CONV_W - 1, W_B), x_prompt.dtype)
    for i in range(DEPTH):
        params = (norm_g[i], w_in[i], ln_v_g[i], ln_v_b[i], w_s[i], b_s[i], conv_w[i],
                  w_a_out[i], w_b_out[i], w_o[i], pe_norm_g[i], w_pe_gate[i], w_pe_proj[i])
        xp, cp, vp = mixer_layer(xp, p_prompt[i], zero_state, *params)
        xs, cs, vs = mixer_layer(xs, p_sample[i], state_conv[i], *params)
        conv_p_list.append(cp)
        conv_s_list.append(cs)
        v_p_list.append(vp)
        v_s_list.append(vs)
    y_prompt = rms_norm(xp, final_norm_g)
    y_sample = rms_norm(xs, final_norm_g)
    conv_state_prompt = jnp.stack(conv_p_list)
    conv_state_sample = jnp.stack(conv_s_list)
    v_rows_prompt = jnp.stack(v_p_list)
    v_rows_sample = jnp.stack(v_s_list)
    return (y_prompt, y_sample, conv_state_prompt, conv_state_sample, v_rows_prompt, v_rows_sample)
```

```cpp
#include <hip/hip_runtime.h>
#include <hip/hip_cooperative_groups.h>
#include <cstdio>
#include <cstdint>
namespace cg = cooperative_groups;

#ifndef MK_N_LAUNCHES
#define MK_N_LAUNCHES 1
#endif

#ifndef MK_REPEAT
#define MK_REPEAT -1
#endif
#define LAS __attribute__((address_space(3)))
typedef unsigned short bf16_t;
typedef short bf16x8 __attribute__((ext_vector_type(8)));
typedef float f32x4 __attribute__((ext_vector_type(4)));
typedef float f32x2 __attribute__((ext_vector_type(2)));
typedef unsigned u32x4 __attribute__((ext_vector_type(4)));
typedef unsigned u32x2 __attribute__((ext_vector_type(2)));
typedef short v4i16_t __attribute__((ext_vector_type(4)));

constexpr int D = 1024, NPROMPT = 8 * 2048, NSAMPLE = 128 * 4, M = NPROMPT + NSAMPLE;
constexpr int NIN = 9 * 1024, PD = 256, NPM = M / 256;
constexpr float EPS = 1e-6f, LN_EPS = 1e-5f;
constexpr size_t O_YP = 0, O_YS = (size_t)NPROMPT * D, O_CP = (size_t)M * D, O_CS = O_CP + 8 * 2 * 1024, O_VP = O_CS + 128 * 2 * 1024, O_VS = O_VP + 8 * 128 * 1024;
constexpr size_t U = (size_t)M * D * 2;
constexpr size_t WS_W1 = 0;
constexpr size_t WS_W2 = WS_W1 + (size_t)NIN * D * 2;
constexpr size_t WS_W3 = WS_W2 + (size_t)2048 * D * 2;
constexpr size_t WS_W4 = WS_W3 + (size_t)D * D * 2;
constexpr size_t WS_W5 = WS_W4 + (size_t)D * D * 2;
constexpr size_t WS_WS = WS_W5 + (size_t)D * PD * 2;
constexpr size_t WS_PB = WS_WS + (size_t)8 * 128 * 128 * 2;
constexpr size_t WS_VST = WS_PB + (size_t)M * PD * 2;
constexpr size_t WS_ST1 = WS_VST + (size_t)M * 16 * 8;
constexpr size_t WS_ST2 = WS_ST1 + (size_t)M * 16 * 4;
constexpr size_t WS_INV = WS_ST2 + (size_t)M * 16 * 4;
constexpr size_t WS_S0 = WS_INV + 131072;
constexpr size_t WS_SMB = WS_S0 + 6 * U;
constexpr size_t WS_CTL = WS_SMB + 6 * 1048576;
constexpr size_t CTL_BYTES = 65536;
constexpr int CW_CNT = 4096;
constexpr size_t WS_END = WS_CTL + CTL_BYTES;
static_assert(WS_END <= 268435456ull, "workspace map exceeds 256 MiB");
static_assert(WS_S0 % 256 == 0 && WS_PB % 256 == 0 && WS_VST % 256 == 0, "alignment");

__device__ __forceinline__ unsigned cvt_pk_bf16(float lo, float hi) { unsigned r; asm volatile("v_cvt_pk_bf16_f32 %0, %1, %2" : "=v"(r) : "v"(lo), "v"(hi)); return r; }
__device__ __forceinline__ unsigned f2bf(float f) { unsigned u = __builtin_bit_cast(unsigned, f); return (u + 0x7fffu + ((u >> 16) & 1u)) >> 16; }
__device__ __forceinline__ float bflo(unsigned w) { return __builtin_bit_cast(float, w << 16); }
__device__ __forceinline__ float bfhi(unsigned w) { return __builtin_bit_cast(float, w & 0xffff0000u); }
__device__ __forceinline__ float fsigmoid(float x) { return __builtin_amdgcn_rcpf(1.0f + __builtin_amdgcn_exp2f(-1.4426950409f * x)); }
__device__ __forceinline__ float fsilu(float x) { return x * fsigmoid(x); }
__device__ __forceinline__ float fgelu(float x) { const float u = x * (1.5957691216f + 0.0713548163f * x * x); return x * fsigmoid(u); }
__device__ __forceinline__ float wave_sum(float v) {
#pragma unroll
    for (int o = 1; o < 64; o <<= 1) v += __shfl_xor(v, o);
    return v;
}
__device__ __forceinline__ unsigned q8(float v) { return (unsigned)(v * 255.0f + 0.5f); }
__device__ __forceinline__ unsigned pack4_u8(float a, float b, float c, float d) { return q8(a) | (q8(b) << 8) | (q8(c) << 16) | (q8(d) << 24); }
#define UNPACK8_U8(V_, F_) do { F_[0] = (float)((V_)[0] & 255u); F_[1] = (float)(((V_)[0] >> 8) & 255u); F_[2] = (float)(((V_)[0] >> 16) & 255u); F_[3] = (float)((V_)[0] >> 24); \
                                F_[4] = (float)((V_)[1] & 255u); F_[5] = (float)(((V_)[1] >> 8) & 255u); F_[6] = (float)(((V_)[1] >> 16) & 255u); F_[7] = (float)((V_)[1] >> 24); } while (0)
#define UNPACK8(V_, F_) do { F_[0] = bflo((V_)[0]); F_[1] = bfhi((V_)[0]); F_[2] = bflo((V_)[1]); F_[3] = bfhi((V_)[1]); F_[4] = bflo((V_)[2]); F_[5] = bfhi((V_)[2]); F_[6] = bflo((V_)[3]); F_[7] = bfhi((V_)[3]); } while (0)

namespace pg8 {
constexpr int BM = 256, BK = 64, HALF = 128, HTB = HALF * BK * 2, STAGE_BYTES = 8 * HTB, NXCD = 8, WGM = 8;
__host__ __device__ __forceinline__ int lds_byte(int r, int c) { const int st = (r >> 4) * 2 + (c >> 5), rr = r & 15, cc = c & 31, ob = rr * 64 + cc * 2; return st * 1024 + (ob ^ (((ob >> 9) & 1) << 5)); }
__host__ __device__ __forceinline__ void stage_rc(int b, int& R, int& C) { const int st = b / 1024, sb = b % 1024, swz = sb ^ (((sb >> 9) & 1) << 5); R = (st >> 1) * 16 + swz / 64; C = (st & 1) * 32 + (swz % 64) / 2; }
__host__ __device__ __forceinline__ int perm32(int rho) { const int n = rho >> 4, i = rho & 15; return 8 * (i >> 2) + 4 * n + (i & 3); }

struct Unit { int pm, pn, rm, rn, half; };
struct Gemm { const bf16_t* A; const bf16_t* Bt; int M, N, K; };

struct StaticOrder {
    int nM, nN, nwg, G, c;
    __host__ __device__ void init(int M_, int N_, int G_, int c_) { nM = M_ / BM; nN = N_ / BM; nwg = nM * nN; G = G_; c = c_; }
    __host__ __device__ bool next(int i, Unit& u) const {
        const long L = (long)i * G + c; if (L >= nwg) return false;
        int wgid = (int)L; { const int q = nwg / NXCD, r = nwg % NXCD, xcd = wgid % NXCD, off = wgid / NXCD; wgid = (xcd < r ? xcd * (q + 1) : r * (q + 1) + (xcd - r) * q) + off; }
        const int nig = WGM * nN, gid = wgid / nig, fm = gid * WGM, gsz = (nM - fm) < WGM ? (nM - fm) : WGM;
        u.pm = fm + ((wgid % nig) % gsz); u.pn = (wgid % nig) / gsz; u.rm = u.pm; u.rn = u.pn; u.half = 0; return true;
    }
    __device__ __forceinline__ void a_ready(const Unit&) const {}
    __device__ __forceinline__ void done(const Unit&) const {}
};
struct PairOrder {
    StaticOrder so; int dM, dN;
    __host__ __device__ void init(int M_, int N_, int G_, int c_, int Mstack) { so.init(M_, N_, G_, c_); dM = Mstack / BM; dN = N_ / BM; }
    __host__ __device__ bool next(int i, Unit& u) const {
        Unit t; if (!so.next(i >> 1, t)) return false;
        const int h = i & 1; u.rm = t.pm; u.rn = t.pn; u.half = h; u.pm = t.pm + h * dM; u.pn = t.pn + h * dN; return true;
    }
    __device__ __forceinline__ void a_ready(const Unit&) const {}
    __device__ __forceinline__ void done(const Unit&) const {}
};

struct SlackOrder {
    int G, c, first, ns;
    __host__ __device__ void init(int G_, int c_, int first_) { G = G_; c = c_; first = (first_ > 0 && first_ < G_) ? first_ : 0; ns = G_ - first; }
    __host__ __device__ bool next(int i, Unit& u) const {
        if (c < first) return false;
        const int idx = (c - first) + i * ns; if (idx >= 256) return false;
        u.pm = u.rm = idx >> 2; u.pn = u.rn = idx & 3; u.half = 0; return true;
    }
    __device__ __forceinline__ void a_ready(const Unit&) const {}
    __device__ __forceinline__ void done(const Unit&) const {}
};

struct P1Order {
    StaticOrder so; int G, c;
    __host__ __device__ void init(int G_, int c_) { so.init(16384, 9216, G_, c_); G = G_; c = c_; }
    __host__ __device__ bool next(int i, Unit& u) const {
        const int L = i * G + c, nwg = 2304; int pm, pn;
        if (L < nwg) { const int q = nwg / NXCD, xcd = L % NXCD, off = L / NXCD, wgid = xcd * q + off;
                       const int nig = WGM * 36, fm = (wgid / nig) * WGM; pm = fm + ((wgid % nig) % WGM); pn = (wgid % nig) / WGM; }
        else { const int idx = L - nwg; if (idx >= 72) return false; pm = 64 + idx / 36; pn = idx % 36; }
        u.pm = pm; u.pn = pn; u.rm = pm; u.rn = pn; u.half = 0; return true;
    }
    __device__ __forceinline__ void a_ready(const Unit&) const {}
    __device__ __forceinline__ void done(const Unit&) const {}
};

template <class Epi, class Sched, bool ALIGN_EPI = false, bool SP2 = false>
__device__ __forceinline__ void gemm_phase(LAS unsigned char* lds, const Gemm g, const Sched& S, const Epi& E) {
    const int tid = threadIdx.x, wid = __builtin_amdgcn_readfirstlane(tid >> 6), lane = tid & 63, wr = wid >> 2, wc = wid & 3, fr = lane & 15, fq = lane >> 4;
    const int K = g.K, nt = K / BK;
    unsigned voffA[2], voffB[2];
#pragma unroll
    for (int i = 0; i < 2; ++i) { int R, C; stage_rc(tid * 16 + i * 8192, R, C); const int Rb = Epi::PERM ? ((R & ~31) + perm32(R & 31)) : R;
        voffA[i] = (unsigned)(R * K + C) * 2u; voffB[i] = (unsigned)(Rb * K + C) * 2u; }
    const size_t kstep = (size_t)(BK * 2);
    const size_t hstep = (size_t)HALF * K * 2;
    const size_t tstep = 2 * hstep;
    const unsigned ldsw = (unsigned)wid * 1024u;
    const int aoff = lds_byte(wr * 64 + fr, fq * 8), boff = lds_byte(wc * 32 + fr, fq * 8);
#define PG8_SA(b, h) (((b) * 2 + (h)) * HTB)
#define PG8_SB(b, h) ((4 + (b) * 2 + (h)) * HTB)
#define PG8_STAGE(bufoff, gbase, voff) do { _Pragma("unroll") for (int _i = 0; _i < 2; ++_i) \
        __builtin_amdgcn_global_load_lds((const unsigned*)((const char*)(gbase) + (voff)[_i]), (LAS unsigned*)(lds + (bufoff) + ldsw + _i * 8192), 16, 0, 0); } while (0)
#define PG8_LDA(dst, b, h) do { _Pragma("unroll") for (int m = 0; m < 4; ++m) _Pragma("unroll") for (int k = 0; k < 2; ++k) dst[m][k] = *(const LAS bf16x8*)(lds + PG8_SA(b, h) + aoff + m * 2048 + k * 1024); } while (0)
#define PG8_LDB(dst, b, h) do { _Pragma("unroll") for (int n = 0; n < 2; ++n) _Pragma("unroll") for (int k = 0; k < 2; ++k) dst[n][k] = *(const LAS bf16x8*)(lds + PG8_SB(b, h) + boff + n * 2048 + k * 1024); } while (0)
#define PG8_MMA(ai, bj, At, Bt) do { __builtin_amdgcn_s_setprio(1); _Pragma("unroll") for (int m = 0; m < 4; ++m) _Pragma("unroll") for (int n = 0; n < 2; ++n) _Pragma("unroll") for (int k = 0; k < 2; ++k) \
        acc[ai][bj][m][n] = __builtin_amdgcn_mfma_f32_16x16x32_bf16(Bt[n][k], At[m][k], acc[ai][bj][m][n], 0, 0, 0); __builtin_amdgcn_s_setprio(0); } while (0)
#define PG8_WAIT_V(n) asm volatile("s_waitcnt vmcnt(" #n ")" ::: "memory")
#define PG8_WAIT_L(n) asm volatile("s_waitcnt lgkmcnt(" #n ")" ::: "memory")
#define PG8_BAR __builtin_amdgcn_s_barrier()
#define PG8_SCHED __builtin_amdgcn_sched_barrier(0)
    Unit cur, nxt; int ui = 0;
    if (!S.next(0, cur)) return;
    f32x4 acc[2][2][4][2];
    E.init(acc, cur, wr, wc, fr, fq);
    bf16x8 At[4][2], B0[2][2], B1[2][2];
    const char* cA = (const char*)g.A + (size_t)cur.pm * tstep; const char* cB = (const char*)g.Bt + (size_t)cur.pn * tstep;
    S.a_ready(cur);
    if constexpr (SP2) {
        PG8_STAGE(PG8_SB(0, 0), cB, voffB); PG8_STAGE(PG8_SB(0, 1), cB + hstep, voffB); PG8_STAGE(PG8_SA(0, 0), cA, voffA); PG8_STAGE(PG8_SA(0, 1), cA + hstep, voffA);
        if (wr == 1) PG8_BAR;
        PG8_WAIT_V(2); PG8_BAR;
        PG8_STAGE(PG8_SB(1, 0), cB + kstep, voffB); PG8_STAGE(PG8_SA(1, 0), cA + kstep, voffA); PG8_STAGE(PG8_SB(1, 1), cB + hstep + kstep, voffB);
        PG8_WAIT_V(6); PG8_BAR;
    } else {
        PG8_STAGE(PG8_SB(0, 0), cB, voffB); PG8_STAGE(PG8_SA(0, 0), cA, voffA); PG8_STAGE(PG8_SB(0, 1), cB + hstep, voffB); PG8_STAGE(PG8_SA(0, 1), cA + hstep, voffA);
        if (wr == 1) PG8_BAR;
        PG8_WAIT_V(4); PG8_BAR;
        PG8_STAGE(PG8_SB(1, 0), cB + kstep, voffB); PG8_STAGE(PG8_SA(1, 0), cA + kstep, voffA); PG8_STAGE(PG8_SB(1, 1), cB + hstep + kstep, voffB);
        PG8_WAIT_V(6); PG8_BAR;
    }
    for (;;) {
        const bool has_next = S.next(ui + 1, nxt);
        const char* nA = has_next ? (const char*)g.A + (size_t)nxt.pm * tstep : cA; const char* nB = has_next ? (const char*)g.Bt + (size_t)nxt.pn * tstep : cB;
#pragma nounroll
        for (int t = 0; t < nt; t += 2) {
            const bool last = (t == nt - 2);
            const char* a1 = cA + (size_t)(t + 1) * kstep;
            const char* a2 = last ? nA : cA + (size_t)(t + 2) * kstep; const char* b2 = last ? nB : cB + (size_t)(t + 2) * kstep;
            const char* a3 = a2 + kstep; const char* b3 = b2 + kstep;
            if (last && has_next) S.a_ready(nxt);
            if constexpr (SP2) {
            PG8_LDB(B0, 0, 0); PG8_LDB(B1, 0, 1); PG8_SCHED; PG8_LDA(At, 0, 0); PG8_STAGE(PG8_SA(1, 1), a1 + hstep, voffA);
            PG8_WAIT_V(8); PG8_WAIT_L(0); PG8_BAR; PG8_MMA(0, 0, At, B0); PG8_MMA(0, 1, At, B1); PG8_BAR; PG8_SCHED;
            PG8_LDA(At, 0, 1); PG8_STAGE(PG8_SB(0, 0), b2, voffB); PG8_STAGE(PG8_SB(0, 1), b2 + hstep, voffB); PG8_STAGE(PG8_SA(0, 0), a2, voffA);
            PG8_WAIT_V(8); PG8_WAIT_L(0); PG8_BAR; PG8_MMA(1, 0, At, B0); PG8_MMA(1, 1, At, B1); PG8_BAR; PG8_SCHED;
            PG8_LDB(B0, 1, 0); PG8_LDB(B1, 1, 1); PG8_SCHED; PG8_LDA(At, 1, 0); PG8_STAGE(PG8_SA(0, 1), a2 + hstep, voffA);
            PG8_WAIT_V(8); PG8_WAIT_L(0); PG8_BAR; PG8_MMA(0, 0, At, B0); PG8_MMA(0, 1, At, B1); PG8_BAR; PG8_SCHED;
            PG8_LDA(At, 1, 1); PG8_STAGE(PG8_SB(1, 0), b3, voffB); PG8_STAGE(PG8_SB(1, 1), b3 + hstep, voffB); PG8_STAGE(PG8_SA(1, 0), a3, voffA);
            PG8_WAIT_V(8); PG8_WAIT_L(0); PG8_BAR; PG8_MMA(1, 0, At, B0); PG8_MMA(1, 1, At, B1); PG8_BAR; PG8_SCHED;
            } else {
            PG8_LDB(B0, 0, 0); PG8_SCHED; PG8_LDA(At, 0, 0); PG8_STAGE(PG8_SA(1, 1), a1 + hstep, voffA);
            PG8_WAIT_L(8); PG8_BAR; PG8_WAIT_L(0); PG8_MMA(0, 0, At, B0); PG8_BAR; PG8_SCHED;
            PG8_LDB(B1, 0, 1); PG8_STAGE(PG8_SB(0, 0), b2, voffB);
            PG8_BAR; PG8_WAIT_L(0); PG8_MMA(0, 1, At, B1); PG8_BAR;
            PG8_LDA(At, 0, 1); PG8_STAGE(PG8_SA(0, 0), a2, voffA);
            PG8_BAR; PG8_WAIT_L(0); PG8_MMA(1, 0, At, B0); PG8_BAR; PG8_SCHED;
            PG8_STAGE(PG8_SB(0, 1), b2 + hstep, voffB);
            PG8_WAIT_V(6); PG8_BAR; PG8_MMA(1, 1, At, B1); PG8_BAR;
            PG8_LDB(B0, 1, 0); PG8_SCHED; PG8_LDA(At, 1, 0); PG8_STAGE(PG8_SA(0, 1), a2 + hstep, voffA);
            PG8_WAIT_L(8); PG8_BAR; PG8_WAIT_L(0); PG8_MMA(0, 0, At, B0); PG8_BAR; PG8_SCHED;
            PG8_LDB(B1, 1, 1); PG8_STAGE(PG8_SB(1, 0), b3, voffB);
            PG8_BAR; PG8_WAIT_L(0); PG8_MMA(0, 1, At, B1); PG8_BAR;
            PG8_LDA(At, 1, 1); PG8_STAGE(PG8_SA(1, 0), a3, voffA);
            PG8_BAR; PG8_WAIT_L(0); PG8_MMA(1, 0, At, B0); PG8_BAR; PG8_SCHED;
            PG8_STAGE(PG8_SB(1, 1), b3 + hstep, voffB);
            PG8_WAIT_V(6); PG8_BAR; PG8_MMA(1, 1, At, B1); PG8_BAR;
            }
        }
        if constexpr (ALIGN_EPI) { if (wr == 0) PG8_BAR; }
        const bool keep = E(acc, cur, wr, wc, fr, fq);
        S.done(cur);
        if (!has_next) break;
        if (!keep) E.init(acc, nxt, wr, wc, fr, fq);
        cur = nxt; cA = nA; cB = nB; ++ui;
        if constexpr (ALIGN_EPI) { if (wr == 1) PG8_BAR; }
    }
    PG8_WAIT_V(0);
    if constexpr (!ALIGN_EPI) { if (wr == 0) PG8_BAR; }
    PG8_BAR;
#undef PG8_SA
#undef PG8_SB
#undef PG8_STAGE
#undef PG8_LDA
#undef PG8_LDB
#undef PG8_MMA
#undef PG8_WAIT_V
#undef PG8_WAIT_L
#undef PG8_BAR
#undef PG8_SCHED
}
}
using pg8::Unit;

__device__ __forceinline__ void acc_zero(f32x4 (&acc)[2][2][4][2]) {
#pragma unroll
    for (int a = 0; a < 2; ++a)
#pragma unroll
        for (int b = 0; b < 2; ++b)
#pragma unroll
            for (int m = 0; m < 4; ++m)
#pragma unroll
                for (int n = 0; n < 2; ++n) acc[a][b][m][n] = (f32x4){0.f, 0.f, 0.f, 0.f};
}
#define EPI_ZERO_INIT __device__ __forceinline__ void init(f32x4 (&acc)[2][2][4][2], const Unit&, int, int, int, int) const { acc_zero(acc); }
#define PACK8(o) ((u32x4){cvt_pk_bf16(o[0], o[1]), cvt_pk_bf16(o[2], o[3]), cvt_pk_bf16(o[4], o[5]), cvt_pk_bf16(o[6], o[7])})

constexpr size_t SM_CHS = 0, SM_BGS = SM_CHS + (size_t)NSAMPLE * 1024, SM_CHF = SM_BGS + (size_t)NSAMPLE * 1024, SM_BGF = SM_CHF + 256 * 2 * 1024, SM_CHL = SM_BGF + 256 * 2 * 1024;
struct Epi1 {
    static constexpr bool PERM = true;
    EPI_ZERO_INIT
    bf16_t *UG, *VG, *SMB; unsigned char* SAq; f32x2* vst; float* out; const float* convw;
    __device__ __forceinline__ bool operator()(f32x4 (&acc)[2][2][4][2], const Unit& u, int wr, int wc, int fr, int fq) const {
        const int pn = u.pn; const int row0 = u.pm * 256 + wr * 64 + fr;
        if (pn < 8) {
            const int col = pn * 128 + wc * 32 + 8 * fq;
#pragma unroll
            for (int ai = 0; ai < 2; ++ai)
#pragma unroll
                for (int m = 0; m < 4; ++m) {
                    const int row = row0 + ai * 128 + m * 16;
                    float o[8];
#pragma unroll
                    for (int i = 0; i < 4; ++i) { o[i] = fgelu(acc[ai][0][m][0][i]) * fsilu(acc[ai][1][m][0][i]); o[4 + i] = fgelu(acc[ai][0][m][1][i]) * fsilu(acc[ai][1][m][1][i]); }
                    *(u32x4*)(UG + (size_t)row * 1024 + col) = PACK8(o);
                }
        } else if (pn < 24) {
            const int col = (pn - 8) * 64 + wc * 16 + 4 * fq; const int lane = fq * 16 + fr;
            const f32x4 w0 = *(const f32x4*)(convw + col), w1 = *(const f32x4*)(convw + 1024 + col), w2 = *(const f32x4*)(convw + 2048 + col);
            bf16_t* YBp = UG + (size_t)M * D;
            const int src1 = (lane & 48) | ((fr + 15) & 15), src2 = (lane & 48) | ((fr + 14) & 15);
#pragma unroll
            for (int ai = 0; ai < 2; ++ai) {
                f32x4 chp = (f32x4){0.f, 0.f, 0.f, 0.f};
#pragma unroll
                for (int m = 0; m < 4; ++m) {
                    const int row = row0 + ai * 128 + m * 16;
                    const f32x4 ch = acc[ai][0][m][0] * acc[ai][0][m][1];
                    f32x4 bg;
#pragma unroll
                    for (int i = 0; i < 4; ++i) bg[i] = acc[ai][1][m][0][i] * fsilu(acc[ai][1][m][1][i]);
                    bool cs; size_t oidx;
                    if (row < NPROMPT) { const int t = row & 2047; cs = t >= 2046; oidx = O_CP + (size_t)((row >> 11) * 2 + (t - 2046)) * 1024 + col; }
                    else { const int r = row - NPROMPT, t = r & 3; cs = t >= 2; oidx = O_CS + (size_t)((r >> 2) * 2 + (t - 2)) * 1024 + col; }
                    if (cs) *(f32x4*)(out + oidx) = ch;
                    const u32x2 chw = (u32x2){cvt_pk_bf16(ch[0], ch[1]), cvt_pk_bf16(ch[2], ch[3])};
                    if (u.pm >= NPROMPT / 256) {
                        const size_t so = (size_t)(row - NPROMPT) * 1024 + col;
                        *(u32x2*)(SMB + SM_CHS + so) = chw; *(u32x2*)(SMB + SM_BGS + so) = (u32x2){cvt_pk_bf16(bg[0], bg[1]), cvt_pk_bf16(bg[2], bg[3])};
                    } else {
                        f32x4 p1, p2;
#pragma unroll
                        for (int i = 0; i < 4; ++i) {
                            const float a1 = __shfl(ch[i], src1), b1 = __shfl(chp[i], src1), a2 = __shfl(ch[i], src2), b2 = __shfl(chp[i], src2);
                            p1[i] = fr == 0 ? b1 : a1; p2[i] = fr < 2 ? b2 : a2;
                        }
                        const int blk = row >> 6;
                        if (m == 0 && fr < 2) {
                            *(u32x2*)(SMB + SM_CHF + (size_t)(blk * 2 + fr) * 1024 + col) = chw;
                            *(u32x2*)(SMB + SM_BGF + (size_t)(blk * 2 + fr) * 1024 + col) = (u32x2){cvt_pk_bf16(bg[0], bg[1]), cvt_pk_bf16(bg[2], bg[3])};
                        } else {
                            const f32x4 y = bg * (w0 * p2 + w1 * p1 + w2 * ch);
                            *(u32x2*)(YBp + (size_t)row * 1024 + col) = (u32x2){cvt_pk_bf16(y[0], y[1]), cvt_pk_bf16(y[2], y[3])};
                        }
                        if (m == 3 && fr >= 14) *(u32x2*)(SMB + SM_CHL + (size_t)(blk * 2 + (fr - 14)) * 1024 + col) = chw;
                    }
                    chp = ch;
                }
            }
        } else {
            const int kind = (pn - 24) >> 2, q = (pn - 24) & 3; bf16_t* O = VG; unsigned char* Oq = SAq + (size_t)(kind == 2 ? 1 : 0) * ((size_t)M * D);
            const int col = q * 256 + wc * 32 + 8 * fq;
#pragma unroll
            for (int ai = 0; ai < 2; ++ai)
#pragma unroll
                for (int m = 0; m < 4; ++m) {
                    const int row = row0 + ai * 128 + m * 16;
                    float s = 0.f, ss = 0.f;
#pragma unroll
                    for (int bj = 0; bj < 2; ++bj) {
                        float a[8], o[8];
#pragma unroll
                        for (int i = 0; i < 4; ++i) { a[i] = acc[ai][bj][m][0][i]; a[4 + i] = acc[ai][bj][m][1][i]; }
                        if (kind == 0) {
#pragma unroll
                            for (int i = 0; i < 8; ++i) { o[i] = fgelu(a[i]); s += o[i]; ss += o[i] * o[i]; }
                            *(u32x4*)(O + (size_t)row * 1024 + col + bj * 128) = PACK8(o);
                        } else {
#pragma unroll
                            for (int i = 0; i < 8; ++i) o[i] = fsigmoid(a[i]);
                            *(u32x2*)(Oq + (size_t)row * 1024 + col + bj * 128) = (u32x2){pack4_u8(o[0], o[1], o[2], o[3]), pack4_u8(o[4], o[5], o[6], o[7])};
                        }
                    }
                    if (kind == 0) {
                        s += __shfl_xor(s, 16); s += __shfl_xor(s, 32); ss += __shfl_xor(ss, 16); ss += __shfl_xor(ss, 32);
                        if (fq == 0) vst[(size_t)row * 16 + q * 4 + wc] = (f32x2){s, ss};
                    }
                }
        }
        return false;
    }
};

struct Epi2 {
    static constexpr bool PERM = true;
    EPI_ZERO_INIT
    const unsigned char *SAq, *SBq; bf16_t* MG;
    __device__ __forceinline__ bool operator()(f32x4 (&acc)[2][2][4][2], const Unit& u, int wr, int wc, int fr, int fq) const {
        const int row0 = u.rm * 256 + wr * 64 + fr, col0 = u.rn * 256 + wc * 32 + 8 * fq;
        u32x2 wb[2][4][2], wa[2][4][2];
#pragma unroll
        for (int ai = 0; ai < 2; ++ai)
#pragma unroll
            for (int m = 0; m < 4; ++m)
#pragma unroll
                for (int bj = 0; bj < 2; ++bj) {
                    const size_t off = (size_t)(row0 + ai * 128 + m * 16) * 1024 + col0 + bj * 128;
                    wb[ai][m][bj] = *(const u32x2*)(SBq + off); if (u.half == 0) wa[ai][m][bj] = *(const u32x2*)(SAq + off);
                }
#pragma unroll
        for (int ai = 0; ai < 2; ++ai)
#pragma unroll
            for (int m = 0; m < 4; ++m)
#pragma unroll
                for (int bj = 0; bj < 2; ++bj) {
                    const size_t off = (size_t)(row0 + ai * 128 + m * 16) * 1024 + col0 + bj * 128;
                    float sb[8]; UNPACK8_U8(wb[ai][m][bj], sb);
                    if (u.half == 0) {
                        float sa[8]; UNPACK8_U8(wa[ai][m][bj], sa);
#pragma unroll
                        for (int i = 0; i < 4; ++i) { acc[ai][bj][m][0][i] *= sa[i] * __builtin_amdgcn_rcpf(fmaxf(sb[i], 0.5f)); acc[ai][bj][m][1][i] *= sa[4 + i] * __builtin_amdgcn_rcpf(fmaxf(sb[4 + i], 0.5f)); }
                    } else {
                        float o[8];
#pragma unroll
                        for (int i = 0; i < 4; ++i) { o[i] = acc[ai][bj][m][0][i] * (fmaxf(sb[i], 0.5f) * (1.0f / 255.0f)); o[4 + i] = acc[ai][bj][m][1][i] * (fmaxf(sb[4 + i], 0.5f) * (1.0f / 255.0f)); }
                        *(u32x4*)(MG + off) = PACK8(o);
                    }
                }
        return u.half == 0;
    }
};

struct EpiP {
    static constexpr bool PERM = true;
    EPI_ZERO_INIT
    bf16_t* O;
    __device__ __forceinline__ bool operator()(f32x4 (&acc)[2][2][4][2], const Unit& u, int wr, int wc, int fr, int fq) const {
        const int row0 = u.rm * 256 + wr * 64 + fr, col0 = u.rn * 256 + wc * 32 + 8 * fq;
#pragma unroll
        for (int ai = 0; ai < 2; ++ai)
#pragma unroll
            for (int m = 0; m < 4; ++m)
#pragma unroll
                for (int bj = 0; bj < 2; ++bj) {
                    float o[8];
#pragma unroll
                    for (int i = 0; i < 4; ++i) { o[i] = acc[ai][bj][m][0][i]; o[4 + i] = acc[ai][bj][m][1][i]; }
                    *(u32x4*)(O + (size_t)(row0 + ai * 128 + m * 16) * 1024 + col0 + bj * 128) = PACK8(o);
                }
        return false;
    }
};

struct EpiRaw {
    static constexpr bool PERM = true;
    EPI_ZERO_INIT
    bf16_t* O;
    __device__ __forceinline__ bool operator()(f32x4 (&acc)[2][2][4][2], const Unit& u, int wr, int wc, int fr, int fq) const {
        const int row0 = u.rm * 256 + wr * 64 + fr, col0 = (u.rn & 3) * 256 + wc * 32 + 8 * fq;
#pragma unroll
        for (int ai = 0; ai < 2; ++ai)
#pragma unroll
            for (int m = 0; m < 4; ++m)
#pragma unroll
                for (int bj = 0; bj < 2; ++bj) {
                    float o[8];
#pragma unroll
                    for (int i = 0; i < 4; ++i) { o[i] = acc[ai][bj][m][0][i]; o[4 + i] = acc[ai][bj][m][1][i]; }
                    *(u32x4*)(O + (size_t)(row0 + ai * 128 + m * 16) * 1024 + col0 + bj * 128) = PACK8(o);
                }
        return false;
    }
};

struct Epi3 {
    static constexpr bool PERM = true;
    const bf16_t* XBn; const float* inv; bf16_t* X1b; float* st1;
    __device__ __forceinline__ void init(f32x4 (&acc)[2][2][4][2], const Unit& u, int wr, int wc, int fr, int fq) const {
        const int row0 = u.rm * 256 + wr * 64 + fr, col0 = u.rn * 256 + wc * 32 + 8 * fq;
        u32x4 xw[2][4][2]; float iv[2][4];
#pragma unroll
        for (int ai = 0; ai < 2; ++ai)
#pragma unroll
            for (int m = 0; m < 4; ++m) {
                iv[ai][m] = inv[row0 + ai * 128 + m * 16];
#pragma unroll
                for (int bj = 0; bj < 2; ++bj) xw[ai][m][bj] = __builtin_nontemporal_load((const u32x4*)(XBn + (size_t)(row0 + ai * 128 + m * 16) * 1024 + col0 + bj * 128));
            }
#pragma unroll
        for (int ai = 0; ai < 2; ++ai)
#pragma unroll
            for (int m = 0; m < 4; ++m)
#pragma unroll
                for (int bj = 0; bj < 2; ++bj) {
                    float xv[8]; UNPACK8(xw[ai][m][bj], xv);
                    acc[ai][bj][m][0] = (f32x4){xv[0], xv[1], xv[2], xv[3]} * iv[ai][m]; acc[ai][bj][m][1] = (f32x4){xv[4], xv[5], xv[6], xv[7]} * iv[ai][m];
                }
    }
    __device__ __forceinline__ bool operator()(f32x4 (&acc)[2][2][4][2], const Unit& u, int wr, int wc, int fr, int fq) const {
        const int row0 = u.rm * 256 + wr * 64 + fr, col0 = u.rn * 256 + wc * 32 + 8 * fq;
#pragma unroll
        for (int ai = 0; ai < 2; ++ai)
#pragma unroll
            for (int m = 0; m < 4; ++m) {
                const int row = row0 + ai * 128 + m * 16;
                float ss = 0.f;
#pragma unroll
                for (int bj = 0; bj < 2; ++bj) {
                    const f32x4 v0 = acc[ai][bj][m][0], v1 = acc[ai][bj][m][1];
                    *(u32x4*)(X1b + (size_t)row * 1024 + col0 + bj * 128) = (u32x4){cvt_pk_bf16(v0[0], v0[1]), cvt_pk_bf16(v0[2], v0[3]), cvt_pk_bf16(v1[0], v1[1]), cvt_pk_bf16(v1[2], v1[3])};
                    ss += (v0[0] * v0[0] + v0[1] * v0[1]) + (v0[2] * v0[2] + v0[3] * v0[3]) + (v1[0] * v1[0] + v1[1] * v1[1]) + (v1[2] * v1[2] + v1[3] * v1[3]);
                }
                ss += __shfl_xor(ss, 16); ss += __shfl_xor(ss, 32);
                if (fq == 0) st1[(size_t)row * 16 + u.rn * 4 + wc] = ss;
            }
        return false;
    }
};

__device__ __forceinline__ void wait_count(unsigned* p, unsigned want) {
    for (unsigned sp = 0; sp < (1u << 20); ++sp) {
        if ((unsigned)__builtin_amdgcn_readfirstlane(__hip_atomic_load(p, __ATOMIC_RELAXED, __HIP_MEMORY_SCOPE_AGENT)) >= want) break;
        __builtin_amdgcn_s_sleep(4);
    }
    __builtin_amdgcn_fence(__ATOMIC_ACQUIRE, "agent");
}
struct Epi4 {
    static constexpr bool PERM = true;
    EPI_ZERO_INIT
    const bf16_t* X1b; const bf16_t* PB; const float* st1; float* out; float* st2; unsigned* cnt; const float* fg; LAS unsigned char* lds;
    __device__ __forceinline__ bool operator()(f32x4 (&acc)[2][2][4][2], const Unit& u, int wr, int wc, int fr, int fq) const {
        const int row0 = u.rm * 256 + wr * 64 + fr, col0 = u.rn * 256 + wc * 32 + 8 * fq;
        const int tidq = (wr * 4 + wc) * 64 + fq * 16 + fr;
        LAS float* Pw = (LAS float*)(lds + 132096);
        LAS float* Sr = Pw + 1024;
#pragma unroll
        for (int ai = 0; ai < 2; ++ai)
#pragma unroll
            for (int mp = 0; mp < 2; ++mp) {
                u32x4 xw[2][2], pw[2][2]; f32x4 p4[2];
#pragma unroll
                for (int mm = 0; mm < 2; ++mm) {
                    const int row = row0 + ai * 128 + (2 * mp + mm) * 16;
                    p4[mm] = *(const f32x4*)(st1 + (size_t)row * 16 + 4 * fq);
#pragma unroll
                    for (int bj = 0; bj < 2; ++bj) { const size_t off = (size_t)row * 1024 + col0 + bj * 128; xw[mm][bj] = *(const u32x4*)(X1b + off); pw[mm][bj] = __builtin_nontemporal_load((const u32x4*)(PB + off)); }
                }
#pragma unroll
                for (int mm = 0; mm < 2; ++mm) {
                    const int m = 2 * mp + mm;
                    float s1 = (p4[mm][0] + p4[mm][1]) + (p4[mm][2] + p4[mm][3]); s1 += __shfl_xor(s1, 16); s1 += __shfl_xor(s1, 32);
                    const float rstd = __builtin_amdgcn_rsqf(s1 * (1.0f / 1024.0f) + EPS);
                    float ss = 0.f;
#pragma unroll
                    for (int bj = 0; bj < 2; ++bj) {
                        float xv[8], pv[8]; UNPACK8(xw[mm][bj], xv); UNPACK8(pw[mm][bj], pv);
                        f32x4 v0, v1;
#pragma unroll
                        for (int i = 0; i < 4; ++i) { v0[i] = xv[i] + fsigmoid(rstd * acc[ai][bj][m][0][i]) * pv[i]; v1[i] = xv[4 + i] + fsigmoid(rstd * acc[ai][bj][m][1][i]) * pv[4 + i]; }
                        acc[ai][bj][m][0] = v0; acc[ai][bj][m][1] = v1;
                        ss += (v0[0] * v0[0] + v0[1] * v0[1]) + (v0[2] * v0[2] + v0[3] * v0[3]) + (v1[0] * v1[0] + v1[1] * v1[1]) + (v1[2] * v1[2] + v1[3] * v1[3]);
                    }
                    ss += __shfl_xor(ss, 16); ss += __shfl_xor(ss, 32);
                    if (fq == 0) Pw[(ai * 128 + wr * 64 + m * 16 + fr) * 4 + wc] = ss;
                }
                asm volatile("" ::: "memory");
            }
        asm volatile("s_waitcnt lgkmcnt(0)" ::: "memory"); __builtin_amdgcn_s_barrier(); asm volatile("" ::: "memory");
        float* slot = st2 + (size_t)(u.rm * 256 + (tidq & 255)) * 16;
        if (tidq < 256) { const f32x4 p = *(const LAS f32x4*)(Pw + tidq * 4);
            __hip_atomic_store(slot + u.rn, (p[0] + p[1]) + (p[2] + p[3]), __ATOMIC_RELAXED, __HIP_MEMORY_SCOPE_AGENT); }
        asm volatile("s_waitcnt vmcnt(0)" ::: "memory"); __builtin_amdgcn_s_barrier(); asm volatile("" ::: "memory");
        unsigned* pc = cnt + 64 * u.rm;
        if (tidq == 0) __hip_atomic_fetch_add(pc, 1u, __ATOMIC_RELAXED, __HIP_MEMORY_SCOPE_AGENT);
        f32x4 gv[2][2];
#pragma unroll
        for (int bj = 0; bj < 2; ++bj) { gv[bj][0] = *(const f32x4*)(fg + col0 + bj * 128); gv[bj][1] = *(const f32x4*)(fg + col0 + bj * 128 + 4); }
        if (tidq < 64) wait_count(pc, 4u);
        asm volatile("s_waitcnt vmcnt(0) lgkmcnt(0)" ::: "memory"); __builtin_amdgcn_s_barrier(); asm volatile("" ::: "memory");
        if (tidq < 256) {
            const unsigned long long q0 = __hip_atomic_load((unsigned long long*)slot, __ATOMIC_RELAXED, __HIP_MEMORY_SCOPE_AGENT), q1 = __hip_atomic_load((unsigned long long*)slot + 1, __ATOMIC_RELAXED, __HIP_MEMORY_SCOPE_AGENT);
            const float s2 = (__uint_as_float((unsigned)q0) + __uint_as_float((unsigned)(q0 >> 32))) + (__uint_as_float((unsigned)q1) + __uint_as_float((unsigned)(q1 >> 32)));
            Sr[tidq] = __builtin_amdgcn_rsqf(s2 * (1.0f / 1024.0f) + EPS);
        }
        asm volatile("s_waitcnt lgkmcnt(0)" ::: "memory"); __builtin_amdgcn_s_barrier(); asm volatile("" ::: "memory");
#pragma unroll
        for (int ai = 0; ai < 2; ++ai)
#pragma unroll
            for (int m = 0; m < 4; ++m) {
                const int rl = ai * 128 + wr * 64 + m * 16 + fr; const float rstd2 = Sr[rl];
#pragma unroll
                for (int bj = 0; bj < 2; ++bj) {
                    const size_t off = (size_t)(u.rm * 256 + rl) * 1024 + col0 + bj * 128;
                    __builtin_nontemporal_store(acc[ai][bj][m][0] * rstd2 * gv[bj][0], (f32x4*)(out + off)); __builtin_nontemporal_store(acc[ai][bj][m][1] * rstd2 * gv[bj][1], (f32x4*)(out + off + 4));
                }
            }
        return false;
    }
};

template <int K>
__device__ __forceinline__ f32x4 thin_gemm(LAS unsigned char* lds, const bf16_t* A, const bf16_t* Bt, int wave, int lane, int tid) {
    const int fr = lane & 15, g4 = lane >> 4, kw = wave * (K / 8);
    f32x4 acc[2][4];
#pragma unroll
    for (int i = 0; i < 2; ++i)
#pragma unroll
        for (int j = 0; j < 4; ++j) acc[i][j] = (f32x4){0.f, 0.f, 0.f, 0.f};
#pragma unroll
    for (int ks = 0; ks < K / 256; ++ks) {
        const int k = kw + 32 * ks + 8 * g4;
        bf16x8 af[2], bf[4];
#pragma unroll
        for (int i = 0; i < 2; ++i) af[i] = *(const bf16x8*)(A + (size_t)(16 * i + fr) * K + k);
#pragma unroll
        for (int j = 0; j < 4; ++j) bf[j] = *(const bf16x8*)(Bt + (size_t)(16 * j + fr) * K + k);
#pragma unroll
        for (int i = 0; i < 2; ++i)
#pragma unroll
            for (int j = 0; j < 4; ++j) acc[i][j] = __builtin_amdgcn_mfma_f32_16x16x32_bf16(bf[j], af[i], acc[i][j], 0, 0, 0);
    }
    LAS float* red = (LAS float*)lds;
#pragma unroll
    for (int i = 0; i < 2; ++i)
#pragma unroll
        for (int j = 0; j < 4; ++j) *(LAS f32x4*)(red + wave * 2176 + (16 * i + fr) * 68 + 16 * j + 4 * g4) = acc[i][j];
    __syncthreads();
    f32x4 sum = (f32x4){0.f, 0.f, 0.f, 0.f};
#pragma unroll
    for (int w = 0; w < 8; ++w) sum += *(const LAS f32x4*)(red + w * 2176 + (tid >> 4) * 68 + 4 * (tid & 15));
    __syncthreads();
    return sum;
}

__device__ __forceinline__ f32x4 thin_gemm_s(LAS unsigned char* lds, const bf16_t* A, const bf16_t* Bt, int wave, int lane, int tid) {
    constexpr int K = 1024, KH = 512, PITCH = 1040;
    const int fr = lane & 15, g4 = lane >> 4;
    f32x4 acc[2][4];
#pragma unroll
    for (int i = 0; i < 2; ++i)
#pragma unroll
        for (int j = 0; j < 4; ++j) acc[i][j] = (f32x4){0.f, 0.f, 0.f, 0.f};
    u32x4 st[12];
#pragma unroll
    for (int i = 0; i < 12; ++i) { const int r = wave * 12 + i; const bf16_t* rp = r < 32 ? A + (size_t)r * K : Bt + (size_t)(r - 32) * K; st[i] = *(const u32x4*)(rp + lane * 8); }
#pragma unroll
    for (int h = 0; h < 2; ++h) {
#pragma unroll
        for (int i = 0; i < 12; ++i) *(LAS u32x4*)(lds + (wave * 12 + i) * PITCH + lane * 16) = st[i];
        __syncthreads();
        if (h == 0) {
#pragma unroll
            for (int i = 0; i < 12; ++i) { const int r = wave * 12 + i; const bf16_t* rp = r < 32 ? A + (size_t)r * K : Bt + (size_t)(r - 32) * K; st[i] = *(const u32x4*)(rp + KH + lane * 8); }
        }
#pragma unroll
        for (int sx = 0; sx < 2; ++sx) {
            const int kb = ((2 * wave + sx) * 32 + 8 * g4) * 2;
            bf16x8 af[2], bf[4];
#pragma unroll
            for (int i = 0; i < 2; ++i) af[i] = *(const LAS bf16x8*)(lds + (16 * i + fr) * PITCH + kb);
#pragma unroll
            for (int j = 0; j < 4; ++j) bf[j] = *(const LAS bf16x8*)(lds + (32 + 16 * j + fr) * PITCH + kb);
#pragma unroll
            for (int i = 0; i < 2; ++i)
#pragma unroll
                for (int j = 0; j < 4; ++j) acc[i][j] = __builtin_amdgcn_mfma_f32_16x16x32_bf16(bf[j], af[i], acc[i][j], 0, 0, 0);
        }
        __syncthreads();
    }
    LAS float* red = (LAS float*)lds;
#pragma unroll
    for (int i = 0; i < 2; ++i)
#pragma unroll
        for (int j = 0; j < 4; ++j) *(LAS f32x4*)(red + wave * 2176 + (16 * i + fr) * 68 + 16 * j + 4 * g4) = acc[i][j];
    __syncthreads();
    f32x4 sum = (f32x4){0.f, 0.f, 0.f, 0.f};
#pragma unroll
    for (int w = 0; w < 8; ++w) sum += *(const LAS f32x4*)(red + w * 2176 + (tid >> 4) * 68 + 4 * (tid & 15));
    __syncthreads();
    return sum;
}

#define XB_TMO      128
#define XB_XCNT(j)  (256  + 64 * (j))
#define XB_XSUB(j)  (1280 + 64 * (j))
#define XB_XGEN(j)  (2304 + 64 * (j))
#define XB_TOP      3328
#define XB_TOPGEN   3392
#define XCD_BAR_WORDS 3456
#define XB_SPIN_CAP (1u << 18)
__device__ __forceinline__ unsigned xb_ld(unsigned* p)              { return __hip_atomic_load(p, __ATOMIC_RELAXED, __HIP_MEMORY_SCOPE_AGENT); }
__device__ __forceinline__ unsigned xb_add(unsigned* p, unsigned v) { return __hip_atomic_fetch_add(p, v, __ATOMIC_RELAXED, __HIP_MEMORY_SCOPE_AGENT); }
__device__ __forceinline__ unsigned xb_xcc_id() { return (unsigned)__builtin_amdgcn_s_getreg((3 << 11) | 20) & 0xFu; }
#define XB_SPIN(cond, bar) do { unsigned _sp = 0; while (cond) { __builtin_amdgcn_s_sleep(1); \
    if ((++_sp & 255u) == 0u) { if (xb_ld(&(bar)[XB_TMO])) break; if (_sp > XB_SPIN_CAP) { atomicAdd(&(bar)[XB_TMO], 1u); break; } } } } while (0)
struct XcdBarrier { unsigned* bar; unsigned x; volatile LAS unsigned* st; };
__device__ __forceinline__ XcdBarrier xcd_barrier_post(unsigned* bar, volatile LAS unsigned* st) {
    XcdBarrier b; b.bar = bar; b.x = xb_xcc_id(); b.st = st;
    if (threadIdx.x == 0) (void)xb_add(&bar[XB_XCNT(b.x)], 1u);
    return b;
}
__device__ __forceinline__ void xcd_barrier_complete(unsigned* bar, unsigned x, unsigned& nloc, unsigned& nx) {
    const unsigned G = gridDim.x * gridDim.y * gridDim.z;
    unsigned sum, cnt, mine, sp = 0u;
    for (;;) {
        sum = 0u; cnt = 0u; mine = 0u;
#pragma unroll
        for (unsigned j = 0; j < 16; ++j) { const unsigned c = xb_ld(&bar[XB_XCNT(j)]); sum += c; cnt += (c > 0u) ? 1u : 0u; mine = (j == x) ? c : mine; }
        if (sum == G) break;
        __builtin_amdgcn_s_sleep(1);
        if ((++sp & 255u) == 0u) { if (xb_ld(&bar[XB_TMO])) break; if (sp > XB_SPIN_CAP) { atomicAdd(&bar[XB_TMO], 1u); break; } }
    }
    nloc = mine > 0u ? mine : 1u; nx = cnt > 0u ? cnt : 1u;
}
__device__ __forceinline__ void xcd_barrier(const XcdBarrier& b) {
    asm volatile("s_waitcnt vmcnt(0)" ::: "memory");
    __syncthreads();
    if (threadIdx.x == 0) {
        unsigned* bar = b.bar;
        __builtin_amdgcn_s_waitcnt(0);
        unsigned nloc = b.st[0], nx = b.st[1];
        if (nloc == 0u) { xcd_barrier_complete(bar, b.x, nloc, nx); b.st[0] = nloc; b.st[1] = nx; }
        const unsigned old = xb_add(&bar[XB_XSUB(b.x)], 1u);
        const unsigned gen = old / nloc;
        if (old + 1u == (gen + 1u) * nloc) {
            __builtin_amdgcn_fence(__ATOMIC_RELEASE, "agent");
            asm volatile("s_waitcnt vmcnt(0)" ::: "memory");
            const unsigned og = xb_add(&bar[XB_TOP], 1u);
            const unsigned tg = og / nx;
            if (og + 1u == (tg + 1u) * nx) xb_add(&bar[XB_TOPGEN], 1u);
            else XB_SPIN(xb_ld(&bar[XB_TOPGEN]) == tg, bar);
            __builtin_amdgcn_fence(__ATOMIC_ACQUIRE, "agent");
            xb_add(&bar[XB_XGEN(b.x)], 1u);
            asm volatile("s_waitcnt vmcnt(0)" ::: "memory");
        } else {
            XB_SPIN(xb_ld(&bar[XB_XGEN(b.x)]) == gen, bar);
            __builtin_amdgcn_fence(__ATOMIC_ACQUIRE, "agent");
            asm volatile("s_waitcnt vmcnt(0)" ::: "memory");
        }
    }
    __syncthreads();
}

constexpr int NWAVES = 8, NTHREADS = 512;
constexpr int LDS_BYTES = 147456;
struct Args { const float* in[19]; float* out; unsigned char* ws; int ph_lo, ph_hi; };

__device__ __forceinline__ void p0_transpose_item(const float* W, int K, int Nsrc, int srccol  , bf16_t* WT, int r0d, const float* ksc, LAS float* scr, int kb, int lane) {
    const int k0 = 64 * kb, nq = lane & 7, kr = lane >> 3;
    f32x4 v[8]; float sc[8];
#pragma unroll
    for (int j = 0; j < 8; ++j) { v[j] = __builtin_nontemporal_load((const f32x4*)(W + (size_t)(k0 + 8 * j + kr) * Nsrc + srccol)); sc[j] = ksc ? ksc[k0 + 8 * j + kr] : 1.0f; }
#pragma unroll
    for (int j = 0; j < 8; ++j) { LAS float* d = scr + (8 * j + kr) * 33 + 4 * nq; d[0] = v[j][0] * sc[j]; d[1] = v[j][1] * sc[j]; d[2] = v[j][2] * sc[j]; d[3] = v[j][3] * sc[j]; }
    asm volatile("s_waitcnt lgkmcnt(0)" ::: "memory");
    const int c = lane & 7;
#pragma unroll
    for (int j = 0; j < 4; ++j) { const int n = (lane >> 3) + 8 * j; const LAS float* s = scr + (8 * c) * 33 + n;
        u32x4 o; o.x = cvt_pk_bf16(s[0 * 33], s[1 * 33]); o.y = cvt_pk_bf16(s[2 * 33], s[3 * 33]); o.z = cvt_pk_bf16(s[4 * 33], s[5 * 33]); o.w = cvt_pk_bf16(s[6 * 33], s[7 * 33]);
        *(u32x4*)(WT + (size_t)(r0d + n) * K + k0 + 8 * c) = o; }
    asm volatile("s_waitcnt lgkmcnt(0)" ::: "memory");
}
__device__ __forceinline__ int w1_src_col(int r) {
    const int pn = r >> 8, j = r & 255;
    if (pn < 8)  return ((j >> 7) ? 2 : 0) * 1024 + 128 * pn + (j & 127);
    if (pn < 24) { const int bj = j >> 7, n = (j >> 2) & 1, wc = (j >> 5) & 3, fq = (j >> 3) & 3; const int sec = bj ? (n ? 6 : 4) : (n ? 5 : 3); return sec * 1024 + 64 * (pn - 8) + 16 * wc + 4 * fq; }
    if (pn < 28) return 1 * 1024 + 256 * (pn - 24) + j;
    if (pn < 32) return 7 * 1024 + 256 * (pn - 28) + j;
    return 8 * 1024 + 256 * (pn - 32) + j;
}

__global__ void __launch_bounds__(NTHREADS, 2) mk_fwd(Args args) {
    extern __shared__ __attribute__((aligned(16))) unsigned char lds_raw[];
    LAS unsigned char* lds = (LAS unsigned char*)lds_raw;
    cg::grid_group grid = cg::this_grid();
    const int tid = threadIdx.x, lane = tid & 63, wave = __builtin_amdgcn_readfirstlane(tid >> 6);
    const int G = gridDim.x, bx = blockIdx.x;
    const int gw = bx * NWAVES + wave, NGW = G * NWAVES;
    unsigned char* ws = args.ws; float* out = args.out;
    const float *x_p = args.in[0], *x_s = args.in[1], *state_conv = args.in[2], *p_p = args.in[3], *p_s = args.in[4], *norm_g = args.in[5], *w_in = args.in[6],
                *ln_g = args.in[7], *ln_b = args.in[8], *w_s = args.in[9], *b_s = args.in[10], *conv_w = args.in[11], *w_a = args.in[12], *w_b = args.in[13], *w_o = args.in[14],
                *pe_g = args.in[15], *w_pg = args.in[16], *w_pp = args.in[17], *fin_g = args.in[18];
    bf16_t *W1 = (bf16_t*)(ws + WS_W1), *W2 = (bf16_t*)(ws + WS_W2), *W3 = (bf16_t*)(ws + WS_W3), *W4 = (bf16_t*)(ws + WS_W4), *W5 = (bf16_t*)(ws + WS_W5), *WS = (bf16_t*)(ws + WS_WS);
    bf16_t* PBIN = (bf16_t*)(ws + WS_PB);
    float* INV = (float*)(ws + WS_INV);
    f32x2* VST = (f32x2*)(ws + WS_VST); float* ST1 = (float*)(ws + WS_ST1); float* ST2 = (float*)(ws + WS_ST2);
    bf16_t *S0 = (bf16_t*)(ws + WS_S0), *S1 = (bf16_t*)(ws + WS_S0 + U), *S2 = (bf16_t*)(ws + WS_S0 + 2 * U), *S3 = (bf16_t*)(ws + WS_S0 + 3 * U), *S4 = (bf16_t*)(ws + WS_S0 + 4 * U), *S5 = (bf16_t*)(ws + WS_S0 + 5 * U);
    bf16_t *XB = S1, *YA = S0, *UG = S2, *YB = S3, *PBUF = S4, *VG = S5, *MG = S2, *X1B = S0; bf16_t* SMB = (bf16_t*)(ws + WS_SMB);
    unsigned char *SAq = (unsigned char*)out, *SBq = (unsigned char*)out + (size_t)M * D;
    const int lo = args.ph_lo, hi = args.ph_hi;
#define IN(k) (lo <= (k) && (k) < hi)
    if (tid < 16) ((LAS unsigned*)(lds + 131072 + 64))[tid] = 0u;
    __syncthreads();
    const XcdBarrier bar = xcd_barrier_post((unsigned*)(ws + WS_CTL), (volatile LAS unsigned*)(lds + 131072 + 64));
    if (hi > 1000) grid.sync();
#define GRID_BAR() xcd_barrier(bar)
#define SEAM(k) do { if (IN(k) && IN((k) + 1)) { GRID_BAR(); if (MK_REPEAT == 11) GRID_BAR(); } } while (0)

    if (IN(0)) for (int rep = 0; rep < (MK_REPEAT == 0 ? 2 : 1); ++rep) { if (rep) GRID_BAR();
        LAS float* scr = (LAS float*)(lds + wave * 16384);
        constexpr int I1 = 16 * 288, I5 = 4 * 32;
        constexpr int NITEMS = I1 + I5;
        for (int it = gw; it < NITEMS; it += NGW) {
            int r = it;
            if (r < I1) { const int kb = r / 288, nb = r % 288; p0_transpose_item(w_in, 1024, NIN, w1_src_col(nb * 32 + 4 * (lane & 7)), W1, nb * 32, norm_g, scr, kb, lane); continue; } r -= I1;
            p0_transpose_item(w_pp, 256, 1024, (r % 32) * 32 + 4 * (lane & 7), W5, (r % 32) * 32, nullptr, scr, r / 32, lane);
        }
        for (int t = 0; ; ++t) {
            int m0;
            if (G == 256) { if (t < 4) m0 = 2048 * (bx & 7) + 64 * (bx >> 3) + 8 * wave + 2 * t; else if (t == 4 && wave == 0) m0 = NPROMPT + 2 * bx; else break; }
            else { m0 = 2 * gw + 2 * NGW * t; if (m0 >= M) break; }
            f32x4 v[2][4], pv[2]; float ssum[2];
#pragma unroll
            for (int r = 0; r < 2; ++r) {
                const int m = m0 + r;
                const float* xr = m < NPROMPT ? x_p + (size_t)m * D : x_s + (size_t)(m - NPROMPT) * D;
                const float* pr = m < NPROMPT ? p_p + (size_t)m * PD : p_s + (size_t)(m - NPROMPT) * PD;
#pragma unroll
                for (int j = 0; j < 4; ++j) v[r][j] = __builtin_nontemporal_load((const f32x4*)(xr + 4 * lane + 256 * j));
                pv[r] = __builtin_nontemporal_load((const f32x4*)(pr + 4 * lane));
            }
#pragma unroll
            for (int r = 0; r < 2; ++r) { float q = 0.f;
#pragma unroll
                for (int j = 0; j < 4; ++j) q += (v[r][j][0] * v[r][j][0] + v[r][j][1] * v[r][j][1]) + (v[r][j][2] * v[r][j][2] + v[r][j][3] * v[r][j][3]);
                ssum[r] = q; }
#pragma unroll
            for (int o = 1; o < 64; o <<= 1) { ssum[0] += __shfl_xor(ssum[0], o); ssum[1] += __shfl_xor(ssum[1], o); }
#pragma unroll
            for (int r = 0; r < 2; ++r) {
                const int m = m0 + r; const float rstd = __builtin_amdgcn_rsqf(ssum[r] * (1.0f / D) + EPS);
                if (lane == 0) INV[m] = __builtin_amdgcn_rcpf(rstd);
#pragma unroll
                for (int j = 0; j < 4; ++j) *(u32x2*)(XB + (size_t)m * D + 4 * lane + 256 * j) = (u32x2){cvt_pk_bf16(v[r][j][0] * rstd, v[r][j][1] * rstd), cvt_pk_bf16(v[r][j][2] * rstd, v[r][j][3] * rstd)};
                *(u32x2*)(PBIN + (size_t)m * PD + 4 * lane) = (u32x2){cvt_pk_bf16(pv[r][0], pv[r][1]), cvt_pk_bf16(pv[r][2], pv[r][3])};
            }
        }
    }
    SEAM(0);
    if (MK_REPEAT == 8) { GRID_BAR(); GRID_BAR(); GRID_BAR(); GRID_BAR(); }

    if (IN(1)) {
        for (int rep = 0; rep < (MK_REPEAT == 1 ? 2 : 1); ++rep) {
        pg8::Gemm g{XB, W1, M, NIN, D}; pg8::P1Order S; S.init(G, bx);
        Epi1 E{UG, VG, SMB, SAq, VST, out, conv_w};
        pg8::gemm_phase<Epi1, pg8::P1Order, true, true>(lds, g, S, E); }
        { pg8::Gemm g2{PBIN, W5, NPROMPT, D, PD}; pg8::SlackOrder S2; S2.init(G, bx, ((M / 256) * (NIN / 256)) % G);
          EpiP E2{PBUF};
          pg8::gemm_phase<EpiP, pg8::SlackOrder, true, true>(lds, g2, S2, E2); }
        {
            const int first = ((M / 256) * (NIN / 256)) % G, ns = (first > 0 ? G - first : G), c2 = (first > 0 ? bx - first : bx);
            LAS float* scr = (LAS float*)(lds + wave * 16384);
            constexpr int I2 = 16 * 32;
            if (c2 >= 0) for (int it = c2 * NWAVES + wave; it < 4 * I2 + 256; it += ns * NWAVES) {
                int r = it;
                if (r < I2) { p0_transpose_item(w_a, 1024, 1024, (r % 32) * 32 + 4 * (lane & 7), W2, (r % 32) * 32, nullptr, scr, r / 32, lane); continue; } r -= I2;
                if (r < I2) { p0_transpose_item(w_b, 1024, 1024, (r % 32) * 32 + 4 * (lane & 7), W2, 1024 + (r % 32) * 32, nullptr, scr, r / 32, lane); continue; } r -= I2;
                if (r < I2) { p0_transpose_item(w_o, 1024, 1024, (r % 32) * 32 + 4 * (lane & 7), W3, (r % 32) * 32, nullptr, scr, r / 32, lane); continue; } r -= I2;
                if (r < I2) { p0_transpose_item(w_pg, 1024, 1024, (r % 32) * 32 + 4 * (lane & 7), W4, (r % 32) * 32, pe_g, scr, r / 32, lane); continue; } r -= I2;
                const int e0 = r * 512 + lane * 8; const int s0 = e0 & 127, t = (e0 >> 7) & 127;
                const f32x4 a = *(const f32x4*)(w_s + e0), b = *(const f32x4*)(w_s + e0 + 4);
                float v[8] = {a[0], a[1], a[2], a[3], b[0], b[1], b[2], b[3]};
#pragma unroll
                for (int i = 0; i < 8; ++i) if (s0 + i > t) v[i] = 0.f;
                *(u32x4*)(WS + e0) = PACK8(v);
            }
        }
    }
    SEAM(1);

    if (IN(2)) for (int rep = 0; rep < (MK_REPEAT == 2 ? 2 : 1); ++rep) { if (rep) GRID_BAR();
        constexpr int NMIX = 512;
        LAS float* ST2L = (LAS float*)(lds + 67584);
        LAS float* ST = ST2L;
        for (int it = 0; ; ++it) {
            int unit;
            if (G == 256) { const int xq = bx & 7, jq = bx >> 3;
                if (it < 2) unit = 64 * xq + jq + 32 * it; else if (it == 2) unit = NMIX + 128 + 32 * xq + jq; else if (it == 3 && bx < 128) unit = NMIX + bx; else break; }
            else { unit = bx + it * G; if (unit >= NMIX + 128 + 256) break; }
            if (unit >= NMIX + 128) {
                const int k = unit - (NMIX + 128), rr = tid >> 8, col = 4 * (tid & 255);
                const bool hist = ((k * 64) & 2047) != 0;
                const u32x2 bgw = *(const u32x2*)(SMB + SM_BGF + (size_t)(k * 2 + rr) * 1024 + col);
                const u32x2 cf0 = *(const u32x2*)(SMB + SM_CHF + (size_t)(k * 2 + 0) * 1024 + col), cf1 = *(const u32x2*)(SMB + SM_CHF + (size_t)(k * 2 + 1) * 1024 + col);
                u32x2 cl0 = (u32x2){0u, 0u}, cl1 = (u32x2){0u, 0u};
                if (hist) { cl0 = *(const u32x2*)(SMB + SM_CHL + (size_t)((k - 1) * 2 + 0) * 1024 + col); cl1 = *(const u32x2*)(SMB + SM_CHL + (size_t)((k - 1) * 2 + 1) * 1024 + col); }
                const f32x4 w0 = *(const f32x4*)(conv_w + col), w1 = *(const f32x4*)(conv_w + 1024 + col), w2 = *(const f32x4*)(conv_w + 2048 + col);
                const u32x2 a2 = rr ? cl1 : cl0, a1 = rr ? cf0 : cl1, a0 = rr ? cf1 : cf0;
                f32x4 y;
                y[0] = bflo(bgw[0]) * (w0[0] * bflo(a2[0]) + w1[0] * bflo(a1[0]) + w2[0] * bflo(a0[0])); y[1] = bfhi(bgw[0]) * (w0[1] * bfhi(a2[0]) + w1[1] * bfhi(a1[0]) + w2[1] * bfhi(a0[0]));
                y[2] = bflo(bgw[1]) * (w0[2] * bflo(a2[1]) + w1[2] * bflo(a1[1]) + w2[2] * bflo(a0[1])); y[3] = bfhi(bgw[1]) * (w0[3] * bfhi(a2[1]) + w1[3] * bfhi(a1[1]) + w2[3] * bfhi(a0[1]));
                *(u32x2*)(YB + (size_t)(k * 64 + rr) * 1024 + col) = (u32x2){cvt_pk_bf16(y[0], y[1]), cvt_pk_bf16(y[2], y[3])};
            } else if (unit < NMIX) {
                const int c = unit >> 2, hp = unit & 3, R0 = c * 128;
                const int cch = tid & 31, rg = tid >> 5, dch = hp * 256 + cch * 8;
                const int hh = wave >> 2, tb = wave & 3, fr = lane & 15, g4 = lane >> 4;
                const int h = hp * 2 + hh;
                f32x2 stv[4];
#pragma unroll
                for (int j = 0; j < 4; ++j) stv[j] = VST[(size_t)(R0 + (tid >> 2)) * 16 + 4 * (tid & 3) + j];
                u32x4 vw[8];
#pragma unroll
                for (int j = 0; j < 8; ++j) vw[j] = __builtin_nontemporal_load((const u32x4*)(VG + (size_t)(R0 + rg + 16 * j) * 1024 + dch));
                const f32x4 g0 = *(const f32x4*)(ln_g + dch), g1 = *(const f32x4*)(ln_g + dch + 4), b0 = *(const f32x4*)(ln_b + dch), b1 = *(const f32x4*)(ln_b + dch + 4);
                const bf16_t* Wh = WS + (size_t)h * 16384;
                u32x2 bWl[4][2], bWh[4][2];
#pragma unroll
                for (int ks = 0; ks < 4; ++ks)
                    if (ks <= tb) {
#pragma unroll
                        for (int n = 0; n < 2; ++n) { const bf16_t* wp = Wh + (size_t)(32 * tb + 16 * n + fr) * 128 + 32 * ks + 4 * g4; bWl[ks][n] = *(const u32x2*)wp; bWh[ks][n] = *(const u32x2*)(wp + 16); }
                    }
                {
                    float s = (stv[0][0] + stv[1][0]) + (stv[2][0] + stv[3][0]), ss = (stv[0][1] + stv[1][1]) + (stv[2][1] + stv[3][1]);
                    s += __shfl_xor(s, 1); ss += __shfl_xor(ss, 1); s += __shfl_xor(s, 2); ss += __shfl_xor(ss, 2);
                    const float mean = s * (1.0f / 1024.0f), var = fmaxf(ss * (1.0f / 1024.0f) - mean * mean, 0.f);
                    if ((tid & 3) == 0) { ST2L[2 * (tid >> 2)] = mean; ST2L[2 * (tid >> 2) + 1] = __builtin_amdgcn_rsqf(var + LN_EPS); }
                }
                __syncthreads();
                u32x4 uw[2][4]; float bsv[2];
#pragma unroll
                for (int n = 0; n < 2; ++n) {
                    const int t = 32 * tb + 16 * n + fr; bsv[n] = b_s[h * 128 + t];
                    const size_t off = (size_t)(R0 + t) * 1024 + h * 128 + 32 * g4;
#pragma unroll
                    for (int k = 0; k < 4; ++k) uw[n][k] = __builtin_nontemporal_load((const u32x4*)(UG + off + 8 * k));
                }
                {
                    const bool lastc = (c & 15) == 15; const int bidx = c >> 4;
                    LAS unsigned char* img = lds + (cch >> 4) * 33792 + (cch & 15) * 16;
#pragma unroll
                    for (int j = 0; j < 8; ++j) {
                        const int sI = rg + 16 * j; float v[8]; UNPACK8(vw[j], v);
                        const float mean = ST2L[2 * sI], rstd = ST2L[2 * sI + 1];
#pragma unroll
                        for (int i = 0; i < 4; ++i) { v[i] = (v[i] - mean) * rstd * g0[i] + b0[i]; v[4 + i] = (v[4 + i] - mean) * rstd * g1[i] + b1[i]; }
                        if (lastc) { float* o = out + O_VP + (size_t)(bidx * 128 + sI) * 1024 + dch; *(f32x4*)o = (f32x4){v[0], v[1], v[2], v[3]}; *(f32x4*)(o + 4) = (f32x4){v[4], v[5], v[6], v[7]}; }
                        *(LAS u32x2*)(img + sI * 264) = (u32x2){cvt_pk_bf16(v[0], v[1]), cvt_pk_bf16(v[2], v[3])};
                        *(LAS u32x2*)(img + sI * 264 + 8) = (u32x2){cvt_pk_bf16(v[4], v[5]), cvt_pk_bf16(v[6], v[7])};
                    }
                }
                __syncthreads();
                {
                    f32x4 acc[8][2];
#pragma unroll
                    for (int a2 = 0; a2 < 8; ++a2)
#pragma unroll
                        for (int b2 = 0; b2 < 2; ++b2) acc[a2][b2] = (f32x4){0.f, 0.f, 0.f, 0.f};
                    const LAS unsigned char* tra = lds + hh * 33792 + (4 * g4 + ((lane & 15) >> 2)) * 264 + (lane & 3) * 64;
#pragma unroll
                    for (int ks = 0; ks < 4; ++ks)
                        if (ks <= tb) {
                            bf16x8 bW[2];
#pragma unroll
                            for (int n = 0; n < 2; ++n) bW[n] = __builtin_bit_cast(bf16x8, (u32x4){bWl[ks][n][0], bWl[ks][n][1], bWh[ks][n][0], bWh[ks][n][1]});
#pragma unroll
                            for (int d = 0; d < 8; ++d) {
                                const v4i16_t lo = __builtin_amdgcn_ds_read_tr16_b64_v4i16((LAS v4i16_t*)(tra + (32 * ks) * 264 + 8 * d));
                                const v4i16_t hi2 = __builtin_amdgcn_ds_read_tr16_b64_v4i16((LAS v4i16_t*)(tra + (32 * ks + 16) * 264 + 8 * d));
                                const bf16x8 aV = (bf16x8){lo[0], lo[1], lo[2], lo[3], hi2[0], hi2[1], hi2[2], hi2[3]};
#pragma unroll
                                for (int n = 0; n < 2; ++n) acc[d][n] = __builtin_amdgcn_mfma_f32_16x16x32_bf16(aV, bW[n], acc[d][n], 0, 0, 0);
                            }
                        }
#pragma unroll
                    for (int n = 0; n < 2; ++n) {
                        const int t = 32 * tb + 16 * n + fr;
                        const size_t off = (size_t)(R0 + t) * 1024 + h * 128 + 32 * g4;
#pragma unroll
                        for (int k = 0; k < 4; ++k) {
                            float ug[8], o[8]; UNPACK8(uw[n][k], ug);
#pragma unroll
                            for (int i = 0; i < 4; ++i) { o[i] = ug[i] * (acc[2 * k][n][i] + bsv[n]); o[4 + i] = ug[4 + i] * (acc[2 * k + 1][n][i] + bsv[n]); }
                            *(u32x4*)(YA + off + 8 * k) = PACK8(o);
                        }
                    }
                }
                __syncthreads();
            } else {
                const int b = unit - NMIX, R0 = NPROMPT + 4 * b;
                if (tid < 4) {
                    const f32x2* vs = VST + (size_t)(R0 + tid) * 16; float s = 0.f, ss = 0.f;
#pragma unroll
                    for (int j = 0; j < 16; ++j) { const f32x2 v = vs[j]; s += v[0]; ss += v[1]; }
                    const float mean = s * (1.0f / 1024.0f), var = fmaxf(ss * (1.0f / 1024.0f) - mean * mean, 0.f);
                    ST[2 * tid] = mean; ST[2 * tid + 1] = __builtin_amdgcn_rsqf(var + LN_EPS);
                }
                __syncthreads();
                {
                    const int ch = 2 * tid, h = ch >> 7;
                    const f32x2 g2 = *(const f32x2*)(ln_g + ch), b2 = *(const f32x2*)(ln_b + ch);
                    float vn[4][2];
#pragma unroll
                    for (int t = 0; t < 4; ++t) {
                        const unsigned w = *(const unsigned*)(VG + (size_t)(R0 + t) * 1024 + ch);
                        const float mean = ST[2 * t], rstd = ST[2 * t + 1];
                        vn[t][0] = (bflo(w) - mean) * rstd * g2[0] + b2[0]; vn[t][1] = (bfhi(w) - mean) * rstd * g2[1] + b2[1];
                        *(f32x2*)(out + O_VS + (size_t)(b * 4 + t) * 1024 + ch) = (f32x2){vn[t][0], vn[t][1]};
                    }
                    const f32x2 c0 = *(const f32x2*)(conv_w + ch), c1 = *(const f32x2*)(conv_w + 1024 + ch), c2 = *(const f32x2*)(conv_w + 2048 + ch);
                    f32x2 q2 = *(const f32x2*)(state_conv + (size_t)(b * 2 + 0) * 1024 + ch), q1 = *(const f32x2*)(state_conv + (size_t)(b * 2 + 1) * 1024 + ch);
#pragma unroll
                    for (int t = 0; t < 4; ++t) {
                        const size_t off = (size_t)(R0 + t) * 1024 + ch;
                        float s0 = b_s[h * 128 + t], s1 = s0;
#pragma unroll
                        for (int s = 0; s <= t; ++s) { const float wv = w_s[(size_t)h * 16384 + t * 128 + s]; s0 += wv * vn[s][0]; s1 += wv * vn[s][1]; }
                        const size_t so = (size_t)(4 * b + t) * 1024 + ch;
                        const unsigned uw = *(const unsigned*)(UG + off), cw = *(const unsigned*)(SMB + SM_CHS + so), bw = *(const unsigned*)(SMB + SM_BGS + so);
                        *(unsigned*)(YA + off) = cvt_pk_bf16(bflo(uw) * s0, bfhi(uw) * s1);
                        const f32x2 cu = (f32x2){bflo(cw), bfhi(cw)};
                        *(unsigned*)(YB + off) = cvt_pk_bf16(bflo(bw) * (c0[0] * q2[0] + c1[0] * q1[0] + c2[0] * cu[0]), bfhi(bw) * (c0[1] * q2[1] + c1[1] * q1[1] + c2[1] * cu[1]));
                        q2 = q1; q1 = cu;
                    }
                }
                __syncthreads();
            }
        }
    }
    SEAM(2);

    if (IN(3)) {
        for (int rep = 0; rep < (MK_REPEAT == 3 ? 2 : 1); ++rep)
        { pg8::Gemm g{YA, W2, NPROMPT, D, D}; pg8::PairOrder S; S.init(NPROMPT, D, G, bx, 3 * M);
          Epi2 E{SAq, SBq, MG};
          pg8::gemm_phase<Epi2, pg8::PairOrder, true, true>(lds, g, S, E); }
        for (int c = bx; c < 256; c += G) {
            const int r0 = NPROMPT + 32 * (c >> 4), c0 = 64 * (c & 15);
            const f32x4 pa = thin_gemm_s(lds, YA + (size_t)r0 * D, W2 + (size_t)c0 * D, wave, lane, tid);
            const f32x4 pb = thin_gemm_s(lds, YB + (size_t)r0 * D, W2 + (size_t)(1024 + c0) * D, wave, lane, tid);
            const size_t off = (size_t)(r0 + (tid >> 4)) * D + c0 + 4 * (tid & 15);
            const unsigned wa = *(const unsigned*)(SAq + off), wb = *(const unsigned*)(SBq + off); const float k = 1.0f / 255.0f;
            *(u32x2*)(MG + off) = (u32x2){cvt_pk_bf16(((float)(wa & 255u) * pa[0] + (float)(wb & 255u) * pb[0]) * k, ((float)((wa >> 8) & 255u) * pa[1] + (float)((wb >> 8) & 255u) * pb[1]) * k),
                                          cvt_pk_bf16(((float)((wa >> 16) & 255u) * pa[2] + (float)((wb >> 16) & 255u) * pb[2]) * k, ((float)(wa >> 24) * pa[3] + (float)(wb >> 24) * pb[3]) * k)};
        }
    }
    SEAM(3);

    if (IN(4)) for (int rep = 0; rep < (MK_REPEAT == 4 ? 2 : 1); ++rep) { if (rep) GRID_BAR();
        { pg8::Gemm g{MG, W3, NPROMPT, D, D}; pg8::StaticOrder S; S.init(NPROMPT, D, G, bx);
          Epi3 E{XB, INV, X1B, ST1};
          pg8::gemm_phase<Epi3, pg8::StaticOrder, true, true>(lds, g, S, E); }
        for (int c = bx; c < 256; c += G) {
            const int r0 = NPROMPT + 32 * (c >> 4), c0 = 64 * (c & 15), row = r0 + (tid >> 4), col = c0 + 4 * (tid & 15);
            const f32x4 xv = *(const f32x4*)(x_s + (size_t)(row - NPROMPT) * D + col);
            const f32x4 v = xv + thin_gemm_s(lds, MG + (size_t)r0 * D, W3 + (size_t)c0 * D, wave, lane, tid);
            *(u32x2*)(X1B + (size_t)row * D + col) = (u32x2){cvt_pk_bf16(v[0], v[1]), cvt_pk_bf16(v[2], v[3])};
            float ss = (v[0] * v[0] + v[1] * v[1]) + (v[2] * v[2] + v[3] * v[3]);
            ss += __shfl_xor(ss, 1); ss += __shfl_xor(ss, 2); ss += __shfl_xor(ss, 4); ss += __shfl_xor(ss, 8);
            if ((tid & 15) == 0) ST1[(size_t)row * 16 + (c & 15)] = ss;
        }
    }
    SEAM(4);

    if (IN(5)) {
        unsigned* CNT = (unsigned*)(ws + WS_CTL) + CW_CNT;
        { pg8::Gemm g{X1B, W4, NPROMPT, D, D}; pg8::StaticOrder S; S.init(NPROMPT, D, G, bx);
          Epi4 E{X1B, PBUF, ST1, out, ST2, CNT, fin_g, lds};
          if (G == 256) pg8::gemm_phase<Epi4, pg8::StaticOrder, true, true>(lds, g, S, E); }
        for (int c = bx; c < 256; c += G) {
            const int r0 = NPROMPT + 32 * (c >> 4), c0 = 64 * (c & 15), row = r0 + (tid >> 4), col = c0 + 4 * (tid & 15);
            const u32x2 xw = *(const u32x2*)(X1B + (size_t)row * D + col);
            float s1 = ST1[(size_t)row * 16 + (tid & 15)];
            s1 += __shfl_xor(s1, 1); s1 += __shfl_xor(s1, 2); s1 += __shfl_xor(s1, 4); s1 += __shfl_xor(s1, 8);
            const float rstd = __builtin_amdgcn_rsqf(s1 * (1.0f / 1024.0f) + EPS);
            const f32x4 gq = thin_gemm_s(lds, X1B + (size_t)r0 * D, W4 + (size_t)c0 * D, wave, lane, tid);
            const f32x4 pq = thin_gemm<256>(lds, PBIN + (size_t)r0 * PD, W5 + (size_t)c0 * PD, wave, lane, tid);
            f32x4 v;
            v[0] = bflo(xw[0]) + fsigmoid(rstd * gq[0]) * pq[0]; v[1] = bfhi(xw[0]) + fsigmoid(rstd * gq[1]) * pq[1];
            v[2] = bflo(xw[1]) + fsigmoid(rstd * gq[2]) * pq[2]; v[3] = bfhi(xw[1]) + fsigmoid(rstd * gq[3]) * pq[3];
            float ss = (v[0] * v[0] + v[1] * v[1]) + (v[2] * v[2] + v[3] * v[3]);
            ss += __shfl_xor(ss, 1); ss += __shfl_xor(ss, 2); ss += __shfl_xor(ss, 4); ss += __shfl_xor(ss, 8);
            if ((tid & 15) == 0) __hip_atomic_store(ST2 + (size_t)row * 16 + (c & 15), ss, __ATOMIC_RELAXED, __HIP_MEMORY_SCOPE_AGENT);
            asm volatile("s_waitcnt vmcnt(0)" ::: "memory");
            __syncthreads();
            unsigned* pc = CNT + 64 * (64 + (c >> 4));
            if (tid == 0) __hip_atomic_fetch_add(pc, 1u, __ATOMIC_RELAXED, __HIP_MEMORY_SCOPE_AGENT);
            if (wave == 0) wait_count(pc, 16u);
            __syncthreads();
            float s2 = __hip_atomic_load(ST2 + (size_t)row * 16 + (tid & 15), __ATOMIC_RELAXED, __HIP_MEMORY_SCOPE_AGENT);
            s2 += __shfl_xor(s2, 1); s2 += __shfl_xor(s2, 2); s2 += __shfl_xor(s2, 4); s2 += __shfl_xor(s2, 8);
            const float rstd2 = __builtin_amdgcn_rsqf(s2 * (1.0f / 1024.0f) + EPS);
            *(f32x4*)(out + (size_t)row * D + col) = v * rstd2 * *(const f32x4*)(fin_g + col);
        }
    }
    if (MK_REPEAT == 107 && IN(7)) {
        pg8::Gemm g{XB, W1, M, NIN, D}; pg8::StaticOrder S; S.init(M, NIN, G, bx);
        EpiRaw E{S0};
        pg8::gemm_phase<EpiRaw, pg8::StaticOrder, true, true>(lds, g, S, E);
    }
#undef IN
#undef SEAM
}

extern "C" void kernel_launch(void* const* d_in, const int* in_sizes, int n_in, void* d_out, int out_size, void* d_ws, size_t ws_size, hipStream_t stream) {
    static int grid = 0;
    if (grid == 0) {
        if (n_in != 19 || ws_size < WS_END) { fprintf(stderr, "kernel_launch: unexpected problem (n_in %d, ws %zu < %zu)\n", n_in, ws_size, (size_t)WS_END); grid = -1; return; }
        int dev = 0, cus = 0, per_cu = 0;
        (void)hipGetDevice(&dev);
        (void)hipDeviceGetAttribute(&cus, hipDeviceAttributeMultiprocessorCount, dev);
        if (hipFuncSetAttribute((const void*)mk_fwd, hipFuncAttributeMaxDynamicSharedMemorySize, LDS_BYTES) != hipSuccess) { fprintf(stderr, "kernel_launch: hipFuncSetAttribute failed\n"); grid = -1; return; }
        if (hipOccupancyMaxActiveBlocksPerMultiprocessor(&per_cu, (const void*)mk_fwd, NTHREADS, LDS_BYTES) != hipSuccess || per_cu < 1) { fprintf(stderr, "kernel_launch: occupancy query says %d\n", per_cu); per_cu = 1; }
        (void)hipGetLastError();
        grid = cus * per_cu;
        if (grid <= 0) grid = 256;
    }
    if (grid < 0) return;
    (void)hipMemsetAsync((unsigned char*)d_ws + WS_CTL, 0, CTL_BYTES, stream);
    if (MK_REPEAT == 12) { (void)hipMemsetAsync((unsigned char*)d_ws + WS_CTL, 0, CTL_BYTES, stream); (void)hipMemsetAsync((unsigned char*)d_ws + WS_CTL, 0, CTL_BYTES, stream); }
    Args a{};
    for (int i = 0; i < 19; ++i) a.in[i] = (const float*)d_in[i];
    a.out = (float*)d_out; a.ws = (unsigned char*)d_ws;
#if MK_N_LAUNCHES == 1
    a.ph_lo = 0; a.ph_hi = 7;
    { void* kargs[] = {&a};
      if (MK_REPEAT == 9) { (void)hipLaunchCooperativeKernel((const void*)mk_fwd, dim3(grid), dim3(NTHREADS), kargs, LDS_BYTES, stream);
                            (void)hipMemsetAsync((unsigned char*)d_ws + WS_CTL, 0, CTL_BYTES, stream); }
      if (MK_REPEAT == 10) { Args e0 = a; e0.ph_lo = 0; e0.ph_hi = 0; void* k0[] = {&e0};
                            (void)hipLaunchCooperativeKernel((const void*)mk_fwd, dim3(grid), dim3(NTHREADS), k0, LDS_BYTES, stream);
                            (void)hipMemsetAsync((unsigned char*)d_ws + WS_CTL, 0, CTL_BYTES, stream); }
      hipError_t e = hipLaunchCooperativeKernel((const void*)mk_fwd, dim3(grid), dim3(NTHREADS), kargs, LDS_BYTES, stream);
      if (e != hipSuccess) fprintf(stderr, "cooperative launch failed: %s (grid %d)\n", hipGetErrorString(e), grid);
      if (MK_REPEAT >= 100) {
          Args e1 = a; e1.ph_lo = MK_REPEAT - 100; e1.ph_hi = MK_REPEAT - 99; void* k1[] = {&e1};
          (void)hipMemsetAsync((unsigned char*)d_ws + WS_CTL, 0, CTL_BYTES, stream);
          (void)hipLaunchCooperativeKernel((const void*)mk_fwd, dim3(grid), dim3(NTHREADS), k1, LDS_BYTES, stream);
          if (MK_REPEAT == 101) { Args e2 = a; e2.ph_lo = 6; e2.ph_hi = 7; void* k2[] = {&e2};
              (void)hipMemsetAsync((unsigned char*)d_ws + WS_CTL, 0, CTL_BYTES, stream);
              (void)hipLaunchCooperativeKernel((const void*)mk_fwd, dim3(grid), dim3(NTHREADS), k2, LDS_BYTES, stream); }
      } }
#else
    for (int ph = 0; ph < 7; ++ph) {
        a.ph_lo = ph; a.ph_hi = ph + 1;
        hipLaunchKernelGGL(mk_fwd, dim3(grid), dim3(NTHREADS), LDS_BYTES, stream, a);
    }
#endif
}
```

```cpp
#include <hip/hip_runtime.h>
#include <hip/hip_cooperative_groups.h>
#include <cstdio>
#include <cstdint>
namespace cg = cooperative_groups;

#ifndef MK_N_LAUNCHES
#define MK_N_LAUNCHES 1
#endif

#ifndef MK_REPEAT
#define MK_REPEAT -1
#endif
#define LAS __attribute__((address_space(3)))
typedef unsigned short bf16_t;
typedef short bf16x8 __attribute__((ext_vector_type(8)));
typedef float f32x4 __attribute__((ext_vector_type(4)));
typedef float f32x2 __attribute__((ext_vector_type(2)));
typedef unsigned u32x4 __attribute__((ext_vector_type(4)));
typedef unsigned u32x2 __attribute__((ext_vector_type(2)));
typedef short v4i16_t __attribute__((ext_vector_type(4)));

constexpr int D = 1024, NPROMPT = 8 * 2048, NSAMPLE = 128 * 4, M = NPROMPT + NSAMPLE;
constexpr int NIN = 9 * 1024, PD = 256, NPM = M / 256;
constexpr float EPS = 1e-6f, LN_EPS = 1e-5f;
constexpr size_t O_YP = 0, O_YS = (size_t)NPROMPT * D, O_CP = (size_t)M * D, O_CS = O_CP + 8 * 2 * 1024, O_VP = O_CS + 128 * 2 * 1024, O_VS = O_VP + 8 * 128 * 1024;
constexpr size_t U = (size_t)M * D * 2;
constexpr size_t WS_W1 = 0;
constexpr size_t WS_W2 = WS_W1 + (size_t)NIN * D * 2;
constexpr size_t WS_W3 = WS_W2 + (size_t)2048 * D * 2;
constexpr size_t WS_W4 = WS_W3 + (size_t)D * D * 2;
constexpr size_t WS_W5 = WS_W4 + (size_t)D * D * 2;
constexpr size_t WS_WS = WS_W5 + (size_t)D * PD * 2;
constexpr size_t WS_PB = WS_WS + (size_t)8 * 128 * 128 * 2;
constexpr size_t WS_VST = WS_PB + (size_t)M * PD * 2;
constexpr size_t WS_ST1 = WS_VST + (size_t)M * 16 * 8;
constexpr size_t WS_ST2 = WS_ST1 + (size_t)M * 16 * 4;
constexpr size_t WS_INV = WS_ST2 + (size_t)M * 16 * 4;
constexpr size_t WS_S0 = WS_INV + 131072;
constexpr size_t WS_CTL = WS_S0 + 6 * U;
constexpr size_t CTL_BYTES = 16384;
constexpr size_t WS_END = WS_CTL + CTL_BYTES;
static_assert(WS_END <= 268435456ull, "workspace map exceeds 256 MiB");
static_assert(WS_S0 % 256 == 0 && WS_PB % 256 == 0 && WS_VST % 256 == 0, "alignment");

__device__ __forceinline__ unsigned cvt_pk_bf16(float lo, float hi) { unsigned r; asm volatile("v_cvt_pk_bf16_f32 %0, %1, %2" : "=v"(r) : "v"(lo), "v"(hi)); return r; }
__device__ __forceinline__ unsigned f2bf(float f) { unsigned u = __builtin_bit_cast(unsigned, f); return (u + 0x7fffu + ((u >> 16) & 1u)) >> 16; }
__device__ __forceinline__ float bflo(unsigned w) { return __builtin_bit_cast(float, w << 16); }
__device__ __forceinline__ float bfhi(unsigned w) { return __builtin_bit_cast(float, w & 0xffff0000u); }
__device__ __forceinline__ float fsigmoid(float x) { return __builtin_amdgcn_rcpf(1.0f + __builtin_amdgcn_exp2f(-1.4426950409f * x)); }
__device__ __forceinline__ float fsilu(float x) { return x * fsigmoid(x); }
__device__ __forceinline__ float fgelu(float x) { const float u = x * (1.5957691216f + 0.0713548163f * x * x); return x * fsigmoid(u); }
__device__ __forceinline__ float wave_sum(float v) {
#pragma unroll
    for (int o = 1; o < 64; o <<= 1) v += __shfl_xor(v, o);
    return v;
}
__device__ __forceinline__ unsigned q8(float v) { return (unsigned)(v * 255.0f + 0.5f); }
__device__ __forceinline__ unsigned pack4_u8(float a, float b, float c, float d) { return q8(a) | (q8(b) << 8) | (q8(c) << 16) | (q8(d) << 24); }
#define UNPACK8_U8(V_, F_) do { F_[0] = (float)((V_)[0] & 255u); F_[1] = (float)(((V_)[0] >> 8) & 255u); F_[2] = (float)(((V_)[0] >> 16) & 255u); F_[3] = (float)((V_)[0] >> 24); \
                                F_[4] = (float)((V_)[1] & 255u); F_[5] = (float)(((V_)[1] >> 8) & 255u); F_[6] = (float)(((V_)[1] >> 16) & 255u); F_[7] = (float)((V_)[1] >> 24); } while (0)
#define UNPACK8(V_, F_) do { F_[0] = bflo((V_)[0]); F_[1] = bfhi((V_)[0]); F_[2] = bflo((V_)[1]); F_[3] = bfhi((V_)[1]); F_[4] = bflo((V_)[2]); F_[5] = bfhi((V_)[2]); F_[6] = bflo((V_)[3]); F_[7] = bfhi((V_)[3]); } while (0)

namespace pg8 {
constexpr int BM = 256, BK = 64, HALF = 128, HTB = HALF * BK * 2, STAGE_BYTES = 8 * HTB, NXCD = 8, WGM = 8;
__host__ __device__ __forceinline__ int lds_byte(int r, int c) { const int st = (r >> 4) * 2 + (c >> 5), rr = r & 15, cc = c & 31, ob = rr * 64 + cc * 2; return st * 1024 + (ob ^ (((ob >> 9) & 1) << 5)); }
__host__ __device__ __forceinline__ void stage_rc(int b, int& R, int& C) { const int st = b / 1024, sb = b % 1024, swz = sb ^ (((sb >> 9) & 1) << 5); R = (st >> 1) * 16 + swz / 64; C = (st & 1) * 32 + (swz % 64) / 2; }
__host__ __device__ __forceinline__ int perm32(int rho) { const int n = rho >> 4, i = rho & 15; return 8 * (i >> 2) + 4 * n + (i & 3); }

struct Unit { int pm, pn, rm, rn, half; };
struct Gemm { const bf16_t* A; const bf16_t* Bt; int M, N, K; };

struct StaticOrder {
    int nM, nN, nwg, G, c;
    __host__ __device__ void init(int M_, int N_, int G_, int c_) { nM = M_ / BM; nN = N_ / BM; nwg = nM * nN; G = G_; c = c_; }
    __host__ __device__ bool next(int i, Unit& u) const {
        const long L = (long)i * G + c; if (L >= nwg) return false;
        int wgid = (int)L; { const int q = nwg / NXCD, r = nwg % NXCD, xcd = wgid % NXCD, off = wgid / NXCD; wgid = (xcd < r ? xcd * (q + 1) : r * (q + 1) + (xcd - r) * q) + off; }
        const int nig = WGM * nN, gid = wgid / nig, fm = gid * WGM, gsz = (nM - fm) < WGM ? (nM - fm) : WGM;
        u.pm = fm + ((wgid % nig) % gsz); u.pn = (wgid % nig) / gsz; u.rm = u.pm; u.rn = u.pn; u.half = 0; return true;
    }
    __device__ __forceinline__ void a_ready(const Unit&) const {}
    __device__ __forceinline__ void done(const Unit&) const {}
};
struct PairOrder {
    StaticOrder so; int dM, dN;
    __host__ __device__ void init(int M_, int N_, int G_, int c_, int Mstack) { so.init(M_, N_, G_, c_); dM = Mstack / BM; dN = N_ / BM; }
    __host__ __device__ bool next(int i, Unit& u) const {
        Unit t; if (!so.next(i >> 1, t)) return false;
        const int h = i & 1; u.rm = t.pm; u.rn = t.pn; u.half = h; u.pm = t.pm + h * dM; u.pn = t.pn + h * dN; return true;
    }
    __device__ __forceinline__ void a_ready(const Unit&) const {}
    __device__ __forceinline__ void done(const Unit&) const {}
};

struct SlackOrder {
    int G, c, first, ns;
    __host__ __device__ void init(int G_, int c_, int first_) { G = G_; c = c_; first = (first_ > 0 && first_ < G_) ? first_ : 0; ns = G_ - first; }
    __host__ __device__ bool next(int i, Unit& u) const {
        if (c < first) return false;
        const int idx = (c - first) + i * ns; if (idx >= 256) return false;
        u.pm = u.rm = idx >> 2; u.pn = u.rn = idx & 3; u.half = 0; return true;
    }
    __device__ __forceinline__ void a_ready(const Unit&) const {}
    __device__ __forceinline__ void done(const Unit&) const {}
};

struct P1Order {
    StaticOrder so; int G, c;
    __host__ __device__ void init(int G_, int c_) { so.init(16384, 9216, G_, c_); G = G_; c = c_; }
    __host__ __device__ bool next(int i, Unit& u) const {
        const int L = i * G + c, nwg = 2304; int pm, pn;
        if (L < nwg) { const int q = nwg / NXCD, xcd = L % NXCD, off = L / NXCD, wgid = xcd * q + off;
                       const int nig = WGM * 36, fm = (wgid / nig) * WGM; pm = fm + ((wgid % nig) % WGM); pn = (wgid % nig) / WGM; }
        else { const int idx = L - nwg; if (idx >= 72) return false; pm = 64 + idx / 36; pn = idx % 36; }
        u.pm = pm; u.pn = pn; u.rm = pm; u.rn = pn; u.half = 0; return true;
    }
    __device__ __forceinline__ void a_ready(const Unit&) const {}
    __device__ __forceinline__ void done(const Unit&) const {}
};

template <class Epi, class Sched, bool ALIGN_EPI = false, bool SP2 = false>
__device__ __forceinline__ void gemm_phase(LAS unsigned char* lds, const Gemm g, const Sched& S, const Epi& E) {
    const int tid = threadIdx.x, wid = __builtin_amdgcn_readfirstlane(tid >> 6), lane = tid & 63, wr = wid >> 2, wc = wid & 3, fr = lane & 15, fq = lane >> 4;
    const int K = g.K, nt = K / BK;
    unsigned voffA[2], voffB[2];
#pragma unroll
    for (int i = 0; i < 2; ++i) { int R, C; stage_rc(tid * 16 + i * 8192, R, C); const int Rb = Epi::PERM ? ((R & ~31) + perm32(R & 31)) : R;
        voffA[i] = (unsigned)(R * K + C) * 2u; voffB[i] = (unsigned)(Rb * K + C) * 2u; }
    const size_t kstep = (size_t)(BK * 2);
    const size_t hstep = (size_t)HALF * K * 2;
    const size_t tstep = 2 * hstep;
    const unsigned ldsw = (unsigned)wid * 1024u;
    const int aoff = lds_byte(wr * 64 + fr, fq * 8), boff = lds_byte(wc * 32 + fr, fq * 8);
#define PG8_SA(b, h) (((b) * 2 + (h)) * HTB)
#define PG8_SB(b, h) ((4 + (b) * 2 + (h)) * HTB)
#define PG8_STAGE(bufoff, gbase, voff) do { _Pragma("unroll") for (int _i = 0; _i < 2; ++_i) \
        __builtin_amdgcn_global_load_lds((const unsigned*)((const char*)(gbase) + (voff)[_i]), (LAS unsigned*)(lds + (bufoff) + ldsw + _i * 8192), 16, 0, 0); } while (0)
#define PG8_LDA(dst, b, h) do { _Pragma("unroll") for (int m = 0; m < 4; ++m) _Pragma("unroll") for (int k = 0; k < 2; ++k) dst[m][k] = *(const LAS bf16x8*)(lds + PG8_SA(b, h) + aoff + m * 2048 + k * 1024); } while (0)
#define PG8_LDB(dst, b, h) do { _Pragma("unroll") for (int n = 0; n < 2; ++n) _Pragma("unroll") for (int k = 0; k < 2; ++k) dst[n][k] = *(const LAS bf16x8*)(lds + PG8_SB(b, h) + boff + n * 2048 + k * 1024); } while (0)
#define PG8_MMA(ai, bj, At, Bt) do { __builtin_amdgcn_s_setprio(1); _Pragma("unroll") for (int m = 0; m < 4; ++m) _Pragma("unroll") for (int n = 0; n < 2; ++n) _Pragma("unroll") for (int k = 0; k < 2; ++k) \
        acc[ai][bj][m][n] = __builtin_amdgcn_mfma_f32_16x16x32_bf16(Bt[n][k], At[m][k], acc[ai][bj][m][n], 0, 0, 0); __builtin_amdgcn_s_setprio(0); } while (0)
#define PG8_WAIT_V(n) asm volatile("s_waitcnt vmcnt(" #n ")" ::: "memory")
#define PG8_WAIT_L(n) asm volatile("s_waitcnt lgkmcnt(" #n ")" ::: "memory")
#define PG8_BAR __builtin_amdgcn_s_barrier()
#define PG8_SCHED __builtin_amdgcn_sched_barrier(0)
    Unit cur, nxt; int ui = 0;
    if (!S.next(0, cur)) return;
    f32x4 acc[2][2][4][2];
    E.init(acc, cur, wr, wc, fr, fq);
    bf16x8 At[4][2], B0[2][2], B1[2][2];
    const char* cA = (const char*)g.A + (size_t)cur.pm * tstep; const char* cB = (const char*)g.Bt + (size_t)cur.pn * tstep;
    S.a_ready(cur);
    if constexpr (SP2) {
        PG8_STAGE(PG8_SB(0, 0), cB, voffB); PG8_STAGE(PG8_SB(0, 1), cB + hstep, voffB); PG8_STAGE(PG8_SA(0, 0), cA, voffA); PG8_STAGE(PG8_SA(0, 1), cA + hstep, voffA);
        if (wr == 1) PG8_BAR;
        PG8_WAIT_V(2); PG8_BAR;
        PG8_STAGE(PG8_SB(1, 0), cB + kstep, voffB); PG8_STAGE(PG8_SA(1, 0), cA + kstep, voffA); PG8_STAGE(PG8_SB(1, 1), cB + hstep + kstep, voffB);
        PG8_WAIT_V(6); PG8_BAR;
    } else {
        PG8_STAGE(PG8_SB(0, 0), cB, voffB); PG8_STAGE(PG8_SA(0, 0), cA, voffA); PG8_STAGE(PG8_SB(0, 1), cB + hstep, voffB); PG8_STAGE(PG8_SA(0, 1), cA + hstep, voffA);
        if (wr == 1) PG8_BAR;
        PG8_WAIT_V(4); PG8_BAR;
        PG8_STAGE(PG8_SB(1, 0), cB + kstep, voffB); PG8_STAGE(PG8_SA(1, 0), cA + kstep, voffA); PG8_STAGE(PG8_SB(1, 1), cB + hstep + kstep, voffB);
        PG8_WAIT_V(6); PG8_BAR;
    }
    for (;;) {
        const bool has_next = S.next(ui + 1, nxt);
        const char* nA = has_next ? (const char*)g.A + (size_t)nxt.pm * tstep : cA; const char* nB = has_next ? (const char*)g.Bt + (size_t)nxt.pn * tstep : cB;
#pragma nounroll
        for (int t = 0; t < nt; t += 2) {
            const bool last = (t == nt - 2);
            const char* a1 = cA + (size_t)(t + 1) * kstep;
            const char* a2 = last ? nA : cA + (size_t)(t + 2) * kstep; const char* b2 = last ? nB : cB + (size_t)(t + 2) * kstep;
            const char* a3 = a2 + kstep; const char* b3 = b2 + kstep;
            if (last && has_next) S.a_ready(nxt);
            if constexpr (SP2) {
            PG8_LDB(B0, 0, 0); PG8_LDB(B1, 0, 1); PG8_SCHED; PG8_LDA(At, 0, 0); PG8_STAGE(PG8_SA(1, 1), a1 + hstep, voffA);
            PG8_WAIT_V(8); PG8_WAIT_L(0); PG8_BAR; PG8_MMA(0, 0, At, B0); PG8_MMA(0, 1, At, B1); PG8_BAR; PG8_SCHED;
            PG8_LDA(At, 0, 1); PG8_STAGE(PG8_SB(0, 0), b2, voffB); PG8_STAGE(PG8_SB(0, 1), b2 + hstep, voffB); PG8_STAGE(PG8_SA(0, 0), a2, voffA);
            PG8_WAIT_V(8); PG8_WAIT_L(0); PG8_BAR; PG8_MMA(1, 0, At, B0); PG8_MMA(1, 1, At, B1); PG8_BAR; PG8_SCHED;
            PG8_LDB(B0, 1, 0); PG8_LDB(B1, 1, 1); PG8_SCHED; PG8_LDA(At, 1, 0); PG8_STAGE(PG8_SA(0, 1), a2 + hstep, voffA);
            PG8_WAIT_V(8); PG8_WAIT_L(0); PG8_BAR; PG8_MMA(0, 0, At, B0); PG8_MMA(0, 1, At, B1); PG8_BAR; PG8_SCHED;
            PG8_LDA(At, 1, 1); PG8_STAGE(PG8_SB(1, 0), b3, voffB); PG8_STAGE(PG8_SB(1, 1), b3 + hstep, voffB); PG8_STAGE(PG8_SA(1, 0), a3, voffA);
            PG8_WAIT_V(8); PG8_WAIT_L(0); PG8_BAR; PG8_MMA(1, 0, At, B0); PG8_MMA(1, 1, At, B1); PG8_BAR; PG8_SCHED;
            } else {
            PG8_LDB(B0, 0, 0); PG8_SCHED; PG8_LDA(At, 0, 0); PG8_STAGE(PG8_SA(1, 1), a1 + hstep, voffA);
            PG8_WAIT_L(8); PG8_BAR; PG8_WAIT_L(0); PG8_MMA(0, 0, At, B0); PG8_BAR; PG8_SCHED;
            PG8_LDB(B1, 0, 1); PG8_STAGE(PG8_SB(0, 0), b2, voffB);
            PG8_BAR; PG8_WAIT_L(0); PG8_MMA(0, 1, At, B1); PG8_BAR;
            PG8_LDA(At, 0, 1); PG8_STAGE(PG8_SA(0, 0), a2, voffA);
            PG8_BAR; PG8_WAIT_L(0); PG8_MMA(1, 0, At, B0); PG8_BAR; PG8_SCHED;
            PG8_STAGE(PG8_SB(0, 1), b2 + hstep, voffB);
            PG8_WAIT_V(6); PG8_BAR; PG8_MMA(1, 1, At, B1); PG8_BAR;
            PG8_LDB(B0, 1, 0); PG8_SCHED; PG8_LDA(At, 1, 0); PG8_STAGE(PG8_SA(0, 1), a2 + hstep, voffA);
            PG8_WAIT_L(8); PG8_BAR; PG8_WAIT_L(0); PG8_MMA(0, 0, At, B0); PG8_BAR; PG8_SCHED;
            PG8_LDB(B1, 1, 1); PG8_STAGE(PG8_SB(1, 0), b3, voffB);
            PG8_BAR; PG8_WAIT_L(0); PG8_MMA(0, 1, At, B1); PG8_BAR;
            PG8_LDA(At, 1, 1); PG8_STAGE(PG8_SA(1, 0), a3, voffA);
            PG8_BAR; PG8_WAIT_L(0); PG8_MMA(1, 0, At, B0); PG8_BAR; PG8_SCHED;
            PG8_STAGE(PG8_SB(1, 1), b3 + hstep, voffB);
            PG8_WAIT_V(6); PG8_BAR; PG8_MMA(1, 1, At, B1); PG8_BAR;
            }
        }
        if constexpr (ALIGN_EPI) { if (wr == 0) PG8_BAR; }
        const bool keep = E(acc, cur, wr, wc, fr, fq);
        S.done(cur);
        if (!has_next) break;
        if (!keep) E.init(acc, nxt, wr, wc, fr, fq);
        cur = nxt; cA = nA; cB = nB; ++ui;
        if constexpr (ALIGN_EPI) { if (wr == 1) PG8_BAR; }
    }
    PG8_WAIT_V(0);
    if constexpr (!ALIGN_EPI) { if (wr == 0) PG8_BAR; }
    PG8_BAR;
#undef PG8_SA
#undef PG8_SB
#undef PG8_STAGE
#undef PG8_LDA
#undef PG8_LDB
#undef PG8_MMA
#undef PG8_WAIT_V
#undef PG8_WAIT_L
#undef PG8_BAR
#undef PG8_SCHED
}
}
using pg8::Unit;

__device__ __forceinline__ void acc_zero(f32x4 (&acc)[2][2][4][2]) {
#pragma unroll
    for (int a = 0; a < 2; ++a)
#pragma unroll
        for (int b = 0; b < 2; ++b)
#pragma unroll
            for (int m = 0; m < 4; ++m)
#pragma unroll
                for (int n = 0; n < 2; ++n) acc[a][b][m][n] = (f32x4){0.f, 0.f, 0.f, 0.f};
}
#define EPI_ZERO_INIT __device__ __forceinline__ void init(f32x4 (&acc)[2][2][4][2], const Unit&, int, int, int, int) const { acc_zero(acc); }
#define PACK8(o) ((u32x4){cvt_pk_bf16(o[0], o[1]), cvt_pk_bf16(o[2], o[3]), cvt_pk_bf16(o[4], o[5]), cvt_pk_bf16(o[6], o[7])})

constexpr size_t SM_CHS = 0, SM_BGS = SM_CHS + (size_t)NSAMPLE * 1024, SM_CHF = SM_BGS + (size_t)NSAMPLE * 1024, SM_BGF = SM_CHF + 256 * 2 * 1024, SM_CHL = SM_BGF + 256 * 2 * 1024;
struct Epi1 {
    static constexpr bool PERM = true;
    EPI_ZERO_INIT
    bf16_t *UG, *VG, *SMB; unsigned char* SAq; f32x2* vst; float* out; const float* convw;
    __device__ __forceinline__ bool operator()(f32x4 (&acc)[2][2][4][2], const Unit& u, int wr, int wc, int fr, int fq) const {
        const int pn = u.pn; const int row0 = u.pm * 256 + wr * 64 + fr;
        if (pn < 8) {
            const int col = pn * 128 + wc * 32 + 8 * fq;
#pragma unroll
            for (int ai = 0; ai < 2; ++ai)
#pragma unroll
                for (int m = 0; m < 4; ++m) {
                    const int row = row0 + ai * 128 + m * 16;
                    float o[8];
#pragma unroll
                    for (int i = 0; i < 4; ++i) { o[i] = fgelu(acc[ai][0][m][0][i]) * fsilu(acc[ai][1][m][0][i]); o[4 + i] = fgelu(acc[ai][0][m][1][i]) * fsilu(acc[ai][1][m][1][i]); }
                    *(u32x4*)(UG + (size_t)row * 1024 + col) = PACK8(o);
                }
        } else if (pn < 24) {
            const int col = (pn - 8) * 64 + wc * 16 + 4 * fq; const int lane = fq * 16 + fr;
            const f32x4 w0 = *(const f32x4*)(convw + col), w1 = *(const f32x4*)(convw + 1024 + col), w2 = *(const f32x4*)(convw + 2048 + col);
            bf16_t* YBp = UG + (size_t)M * D;
            const int src1 = (lane & 48) | ((fr + 15) & 15), src2 = (lane & 48) | ((fr + 14) & 15);
#pragma unroll
            for (int ai = 0; ai < 2; ++ai) {
                f32x4 chp = (f32x4){0.f, 0.f, 0.f, 0.f};
#pragma unroll
                for (int m = 0; m < 4; ++m) {
                    const int row = row0 + ai * 128 + m * 16;
                    const f32x4 ch = acc[ai][0][m][0] * acc[ai][0][m][1];
                    f32x4 bg;
#pragma unroll
                    for (int i = 0; i < 4; ++i) bg[i] = acc[ai][1][m][0][i] * fsilu(acc[ai][1][m][1][i]);
                    bool cs; size_t oidx;
                    if (row < NPROMPT) { const int t = row & 2047; cs = t >= 2046; oidx = O_CP + (size_t)((row >> 11) * 2 + (t - 2046)) * 1024 + col; }
                    else { const int r = row - NPROMPT, t = r & 3; cs = t >= 2; oidx = O_CS + (size_t)((r >> 2) * 2 + (t - 2)) * 1024 + col; }
                    if (cs) *(f32x4*)(out + oidx) = ch;
                    const u32x2 chw = (u32x2){cvt_pk_bf16(ch[0], ch[1]), cvt_pk_bf16(ch[2], ch[3])};
                    if (u.pm >= NPROMPT / 256) {
                        const size_t so = (size_t)(row - NPROMPT) * 1024 + col;
                        *(u32x2*)(SMB + SM_CHS + so) = chw; *(u32x2*)(SMB + SM_BGS + so) = (u32x2){cvt_pk_bf16(bg[0], bg[1]), cvt_pk_bf16(bg[2], bg[3])};
                    } else {
                        f32x4 p1, p2;
#pragma unroll
                        for (int i = 0; i < 4; ++i) {
                            const float a1 = __shfl(ch[i], src1), b1 = __shfl(chp[i], src1), a2 = __shfl(ch[i], src2), b2 = __shfl(chp[i], src2);
                            p1[i] = fr == 0 ? b1 : a1; p2[i] = fr < 2 ? b2 : a2;
                        }
                        const int blk = row >> 6;
                        if (m == 0 && fr < 2) {
                            *(u32x2*)(SMB + SM_CHF + (size_t)(blk * 2 + fr) * 1024 + col) = chw;
                            *(u32x2*)(SMB + SM_BGF + (size_t)(blk * 2 + fr) * 1024 + col) = (u32x2){cvt_pk_bf16(bg[0], bg[1]), cvt_pk_bf16(bg[2], bg[3])};
                        } else {
                            const f32x4 y = bg * (w0 * p2 + w1 * p1 + w2 * ch);
                            *(u32x2*)(YBp + (size_t)row * 1024 + col) = (u32x2){cvt_pk_bf16(y[0], y[1]), cvt_pk_bf16(y[2], y[3])};
                        }
                        if (m == 3 && fr >= 14) *(u32x2*)(SMB + SM_CHL + (size_t)(blk * 2 + (fr - 14)) * 1024 + col) = chw;
                    }
                    chp = ch;
                }
            }
        } else {
            const int kind = (pn - 24) >> 2, q = (pn - 24) & 3; bf16_t* O = VG; unsigned char* Oq = SAq + (size_t)(kind == 2 ? 1 : 0) * ((size_t)M * D);
            const int col = q * 256 + wc * 32 + 8 * fq;
#pragma unroll
            for (int ai = 0; ai < 2; ++ai)
#pragma unroll
                for (int m = 0; m < 4; ++m) {
                    const int row = row0 + ai * 128 + m * 16;
                    float s = 0.f, ss = 0.f;
#pragma unroll
                    for (int bj = 0; bj < 2; ++bj) {
                        float a[8], o[8];
#pragma unroll
                        for (int i = 0; i < 4; ++i) { a[i] = acc[ai][bj][m][0][i]; a[4 + i] = acc[ai][bj][m][1][i]; }
                        if (kind == 0) {
#pragma unroll
                            for (int i = 0; i < 8; ++i) { o[i] = fgelu(a[i]); s += o[i]; ss += o[i] * o[i]; }
                            *(u32x4*)(O + (size_t)row * 1024 + col + bj * 128) = PACK8(o);
                        } else {
#pragma unroll
                            for (int i = 0; i < 8; ++i) o[i] = fsigmoid(a[i]);
                            *(u32x2*)(Oq + (size_t)row * 1024 + col + bj * 128) = (u32x2){pack4_u8(o[0], o[1], o[2], o[3]), pack4_u8(o[4], o[5], o[6], o[7])};
                        }
                    }
                    if (kind == 0) {
                        s += __shfl_xor(s, 16); s += __shfl_xor(s, 32); ss += __shfl_xor(ss, 16); ss += __shfl_xor(ss, 32);
                        if (fq == 0) vst[(size_t)row * 16 + q * 4 + wc] = (f32x2){s, ss};
                    }
                }
        }
        return false;
    }
};

struct Epi2 {
    static constexpr bool PERM = true;
    EPI_ZERO_INIT
    const unsigned char *SAq, *SBq; bf16_t* MG;
    __device__ __forceinline__ bool operator()(f32x4 (&acc)[2][2][4][2], const Unit& u, int wr, int wc, int fr, int fq) const {
        const int row0 = u.rm * 256 + wr * 64 + fr, col0 = u.rn * 256 + wc * 32 + 8 * fq;
        u32x2 wb[2][4][2], wa[2][4][2];
#pragma unroll
        for (int ai = 0; ai < 2; ++ai)
#pragma unroll
            for (int m = 0; m < 4; ++m)
#pragma unroll
                for (int bj = 0; bj < 2; ++bj) {
                    const size_t off = (size_t)(row0 + ai * 128 + m * 16) * 1024 + col0 + bj * 128;
                    wb[ai][m][bj] = *(const u32x2*)(SBq + off); if (u.half == 0) wa[ai][m][bj] = *(const u32x2*)(SAq + off);
                }
#pragma unroll
        for (int ai = 0; ai < 2; ++ai)
#pragma unroll
            for (int m = 0; m < 4; ++m)
#pragma unroll
                for (int bj = 0; bj < 2; ++bj) {
                    const size_t off = (size_t)(row0 + ai * 128 + m * 16) * 1024 + col0 + bj * 128;
                    float sb[8]; UNPACK8_U8(wb[ai][m][bj], sb);
                    if (u.half == 0) {
                        float sa[8]; UNPACK8_U8(wa[ai][m][bj], sa);
#pragma unroll
                        for (int i = 0; i < 4; ++i) { acc[ai][bj][m][0][i] *= sa[i] * __builtin_amdgcn_rcpf(fmaxf(sb[i], 0.5f)); acc[ai][bj][m][1][i] *= sa[4 + i] * __builtin_amdgcn_rcpf(fmaxf(sb[4 + i], 0.5f)); }
                    } else {
                        float o[8];
#pragma unroll
                        for (int i = 0; i < 4; ++i) { o[i] = acc[ai][bj][m][0][i] * (fmaxf(sb[i], 0.5f) * (1.0f / 255.0f)); o[4 + i] = acc[ai][bj][m][1][i] * (fmaxf(sb[4 + i], 0.5f) * (1.0f / 255.0f)); }
                        *(u32x4*)(MG + off) = PACK8(o);
                    }
                }
        return u.half == 0;
    }
};

struct EpiP {
    static constexpr bool PERM = true;
    EPI_ZERO_INIT
    bf16_t* O;
    __device__ __forceinline__ bool operator()(f32x4 (&acc)[2][2][4][2], const Unit& u, int wr, int wc, int fr, int fq) const {
        const int row0 = u.rm * 256 + wr * 64 + fr, col0 = u.rn * 256 + wc * 32 + 8 * fq;
#pragma unroll
        for (int ai = 0; ai < 2; ++ai)
#pragma unroll
            for (int m = 0; m < 4; ++m)
#pragma unroll
                for (int bj = 0; bj < 2; ++bj) {
                    float o[8];
#pragma unroll
                    for (int i = 0; i < 4; ++i) { o[i] = acc[ai][bj][m][0][i]; o[4 + i] = acc[ai][bj][m][1][i]; }
                    *(u32x4*)(O + (size_t)(row0 + ai * 128 + m * 16) * 1024 + col0 + bj * 128) = PACK8(o);
                }
        return false;
    }
};

struct EpiRaw {
    static constexpr bool PERM = true;
    EPI_ZERO_INIT
    bf16_t* O;
    __device__ __forceinline__ bool operator()(f32x4 (&acc)[2][2][4][2], const Unit& u, int wr, int wc, int fr, int fq) const {
        const int row0 = u.rm * 256 + wr * 64 + fr, col0 = (u.rn & 3) * 256 + wc * 32 + 8 * fq;
#pragma unroll
        for (int ai = 0; ai < 2; ++ai)
#pragma unroll
            for (int m = 0; m < 4; ++m)
#pragma unroll
                for (int bj = 0; bj < 2; ++bj) {
                    float o[8];
#pragma unroll
                    for (int i = 0; i < 4; ++i) { o[i] = acc[ai][bj][m][0][i]; o[4 + i] = acc[ai][bj][m][1][i]; }
                    *(u32x4*)(O + (size_t)(row0 + ai * 128 + m * 16) * 1024 + col0 + bj * 128) = PACK8(o);
                }
        return false;
    }
};

struct Epi3 {
    static constexpr bool PERM = true;
    const bf16_t* XBn; const float* inv; bf16_t* X1b; float* st1;
    __device__ __forceinline__ void init(f32x4 (&acc)[2][2][4][2], const Unit& u, int wr, int wc, int fr, int fq) const {
        const int row0 = u.rm * 256 + wr * 64 + fr, col0 = u.rn * 256 + wc * 32 + 8 * fq;
        u32x4 xw[2][4][2]; float iv[2][4];
#pragma unroll
        for (int ai = 0; ai < 2; ++ai)
#pragma unroll
            for (int m = 0; m < 4; ++m) {
                iv[ai][m] = inv[row0 + ai * 128 + m * 16];
#pragma unroll
                for (int bj = 0; bj < 2; ++bj) xw[ai][m][bj] = __builtin_nontemporal_load((const u32x4*)(XBn + (size_t)(row0 + ai * 128 + m * 16) * 1024 + col0 + bj * 128));
            }
#pragma unroll
        for (int ai = 0; ai < 2; ++ai)
#pragma unroll
            for (int m = 0; m < 4; ++m)
#pragma unroll
                for (int bj = 0; bj < 2; ++bj) {
                    float xv[8]; UNPACK8(xw[ai][m][bj], xv);
                    acc[ai][bj][m][0] = (f32x4){xv[0], xv[1], xv[2], xv[3]} * iv[ai][m]; acc[ai][bj][m][1] = (f32x4){xv[4], xv[5], xv[6], xv[7]} * iv[ai][m];
                }
    }
    __device__ __forceinline__ bool operator()(f32x4 (&acc)[2][2][4][2], const Unit& u, int wr, int wc, int fr, int fq) const {
        const int row0 = u.rm * 256 + wr * 64 + fr, col0 = u.rn * 256 + wc * 32 + 8 * fq;
#pragma unroll
        for (int ai = 0; ai < 2; ++ai)
#pragma unroll
            for (int m = 0; m < 4; ++m) {
                const int row = row0 + ai * 128 + m * 16;
                float ss = 0.f;
#pragma unroll
                for (int bj = 0; bj < 2; ++bj) {
                    const f32x4 v0 = acc[ai][bj][m][0], v1 = acc[ai][bj][m][1];
                    *(u32x4*)(X1b + (size_t)row * 1024 + col0 + bj * 128) = (u32x4){cvt_pk_bf16(v0[0], v0[1]), cvt_pk_bf16(v0[2], v0[3]), cvt_pk_bf16(v1[0], v1[1]), cvt_pk_bf16(v1[2], v1[3])};
                    ss += (v0[0] * v0[0] + v0[1] * v0[1]) + (v0[2] * v0[2] + v0[3] * v0[3]) + (v1[0] * v1[0] + v1[1] * v1[1]) + (v1[2] * v1[2] + v1[3] * v1[3]);
                }
                ss += __shfl_xor(ss, 16); ss += __shfl_xor(ss, 32);
                if (fq == 0) st1[(size_t)row * 16 + u.rn * 4 + wc] = ss;
            }
        return false;
    }
};

struct Epi4 {
    static constexpr bool PERM = true;
    EPI_ZERO_INIT
    const bf16_t* X1b; const bf16_t* PB; const float* st1; bf16_t* X2b; float* st2;
    __device__ __forceinline__ bool operator()(f32x4 (&acc)[2][2][4][2], const Unit& u, int wr, int wc, int fr, int fq) const {
        const int row0 = u.rm * 256 + wr * 64 + fr, col0 = u.rn * 256 + wc * 32 + 8 * fq;
#pragma unroll
        for (int ai = 0; ai < 2; ++ai)
#pragma unroll
            for (int mp = 0; mp < 2; ++mp) {
                u32x4 xw[2][2], pw[2][2]; f32x4 p4[2];
#pragma unroll
                for (int mm = 0; mm < 2; ++mm) {
                    const int row = row0 + ai * 128 + (2 * mp + mm) * 16;
                    p4[mm] = *(const f32x4*)(st1 + (size_t)row * 16 + 4 * fq);
#pragma unroll
                    for (int bj = 0; bj < 2; ++bj) { const size_t off = (size_t)row * 1024 + col0 + bj * 128; xw[mm][bj] = *(const u32x4*)(X1b + off); pw[mm][bj] = __builtin_nontemporal_load((const u32x4*)(PB + off)); }
                }
#pragma unroll
                for (int mm = 0; mm < 2; ++mm) {
                    const int m = 2 * mp + mm, row = row0 + ai * 128 + m * 16;
                    float s1 = (p4[mm][0] + p4[mm][1]) + (p4[mm][2] + p4[mm][3]); s1 += __shfl_xor(s1, 16); s1 += __shfl_xor(s1, 32);
                    const float rstd = __builtin_amdgcn_rsqf(s1 * (1.0f / 1024.0f) + EPS);
                    float ss = 0.f;
#pragma unroll
                    for (int bj = 0; bj < 2; ++bj) {
                        const size_t off = (size_t)row * 1024 + col0 + bj * 128;
                        float xv[8], pv[8]; UNPACK8(xw[mm][bj], xv); UNPACK8(pw[mm][bj], pv);
                        f32x4 v0, v1;
#pragma unroll
                        for (int i = 0; i < 4; ++i) { v0[i] = xv[i] + fsigmoid(rstd * acc[ai][bj][m][0][i]) * pv[i]; v1[i] = xv[4 + i] + fsigmoid(rstd * acc[ai][bj][m][1][i]) * pv[4 + i]; }
                        *(u32x4*)(X2b + off) = (u32x4){cvt_pk_bf16(v0[0], v0[1]), cvt_pk_bf16(v0[2], v0[3]), cvt_pk_bf16(v1[0], v1[1]), cvt_pk_bf16(v1[2], v1[3])};
                        ss += (v0[0] * v0[0] + v0[1] * v0[1]) + (v0[2] * v0[2] + v0[3] * v0[3]) + (v1[0] * v1[0] + v1[1] * v1[1]) + (v1[2] * v1[2] + v1[3] * v1[3]);
                    }
                    ss += __shfl_xor(ss, 16); ss += __shfl_xor(ss, 32);
                    if (fq == 0) st2[(size_t)row * 16 + u.rn * 4 + wc] = ss;
                }
                asm volatile("" ::: "memory");
            }
        return false;
    }
};

template <int K>
__device__ __forceinline__ f32x4 thin_gemm(LAS unsigned char* lds, const bf16_t* A, const bf16_t* Bt, int wave, int lane, int tid) {
    const int fr = lane & 15, g4 = lane >> 4, kw = wave * (K / 8);
    f32x4 acc[2][4];
#pragma unroll
    for (int i = 0; i < 2; ++i)
#pragma unroll
        for (int j = 0; j < 4; ++j) acc[i][j] = (f32x4){0.f, 0.f, 0.f, 0.f};
#pragma unroll
    for (int ks = 0; ks < K / 256; ++ks) {
        const int k = kw + 32 * ks + 8 * g4;
        bf16x8 af[2], bf[4];
#pragma unroll
        for (int i = 0; i < 2; ++i) af[i] = *(const bf16x8*)(A + (size_t)(16 * i + fr) * K + k);
#pragma unroll
        for (int j = 0; j < 4; ++j) bf[j] = *(const bf16x8*)(Bt + (size_t)(16 * j + fr) * K + k);
#pragma unroll
        for (int i = 0; i < 2; ++i)
#pragma unroll
            for (int j = 0; j < 4; ++j) acc[i][j] = __builtin_amdgcn_mfma_f32_16x16x32_bf16(bf[j], af[i], acc[i][j], 0, 0, 0);
    }
    LAS float* red = (LAS float*)lds;
#pragma unroll
    for (int i = 0; i < 2; ++i)
#pragma unroll
        for (int j = 0; j < 4; ++j) *(LAS f32x4*)(red + wave * 2176 + (16 * i + fr) * 68 + 16 * j + 4 * g4) = acc[i][j];
    __syncthreads();
    f32x4 sum = (f32x4){0.f, 0.f, 0.f, 0.f};
#pragma unroll
    for (int w = 0; w < 8; ++w) sum += *(const LAS f32x4*)(red + w * 2176 + (tid >> 4) * 68 + 4 * (tid & 15));
    __syncthreads();
    return sum;
}

__device__ __forceinline__ f32x4 thin_gemm_s(LAS unsigned char* lds, const bf16_t* A, const bf16_t* Bt, int wave, int lane, int tid) {
    constexpr int K = 1024, KH = 512, PITCH = 1040;
    const int fr = lane & 15, g4 = lane >> 4;
    f32x4 acc[2][4];
#pragma unroll
    for (int i = 0; i < 2; ++i)
#pragma unroll
        for (int j = 0; j < 4; ++j) acc[i][j] = (f32x4){0.f, 0.f, 0.f, 0.f};
    u32x4 st[12];
#pragma unroll
    for (int i = 0; i < 12; ++i) { const int r = wave * 12 + i; const bf16_t* rp = r < 32 ? A + (size_t)r * K : Bt + (size_t)(r - 32) * K; st[i] = *(const u32x4*)(rp + lane * 8); }
#pragma unroll
    for (int h = 0; h < 2; ++h) {
#pragma unroll
        for (int i = 0; i < 12; ++i) *(LAS u32x4*)(lds + (wave * 12 + i) * PITCH + lane * 16) = st[i];
        __syncthreads();
        if (h == 0) {
#pragma unroll
            for (int i = 0; i < 12; ++i) { const int r = wave * 12 + i; const bf16_t* rp = r < 32 ? A + (size_t)r * K : Bt + (size_t)(r - 32) * K; st[i] = *(const u32x4*)(rp + KH + lane * 8); }
        }
#pragma unroll
        for (int sx = 0; sx < 2; ++sx) {
            const int kb = ((2 * wave + sx) * 32 + 8 * g4) * 2;
            bf16x8 af[2], bf[4];
#pragma unroll
            for (int i = 0; i < 2; ++i) af[i] = *(const LAS bf16x8*)(lds + (16 * i + fr) * PITCH + kb);
#pragma unroll
            for (int j = 0; j < 4; ++j) bf[j] = *(const LAS bf16x8*)(lds + (32 + 16 * j + fr) * PITCH + kb);
#pragma unroll
            for (int i = 0; i < 2; ++i)
#pragma unroll
                for (int j = 0; j < 4; ++j) acc[i][j] = __builtin_amdgcn_mfma_f32_16x16x32_bf16(bf[j], af[i], acc[i][j], 0, 0, 0);
        }
        __syncthreads();
    }
    LAS float* red = (LAS float*)lds;
#pragma unroll
    for (int i = 0; i < 2; ++i)
#pragma unroll
        for (int j = 0; j < 4; ++j) *(LAS f32x4*)(red + wave * 2176 + (16 * i + fr) * 68 + 16 * j + 4 * g4) = acc[i][j];
    __syncthreads();
    f32x4 sum = (f32x4){0.f, 0.f, 0.f, 0.f};
#pragma unroll
    for (int w = 0; w < 8; ++w) sum += *(const LAS f32x4*)(red + w * 2176 + (tid >> 4) * 68 + 4 * (tid & 15));
    __syncthreads();
    return sum;
}

#define XB_TMO      128
#define XB_XCNT(j)  (256  + 64 * (j))
#define XB_XSUB(j)  (1280 + 64 * (j))
#define XB_XGEN(j)  (2304 + 64 * (j))
#define XB_TOP      3328
#define XB_TOPGEN   3392
#define XCD_BAR_WORDS 3456
#define XB_SPIN_CAP (1u << 18)
__device__ __forceinline__ unsigned xb_ld(unsigned* p)              { return __hip_atomic_load(p, __ATOMIC_RELAXED, __HIP_MEMORY_SCOPE_AGENT); }
__device__ __forceinline__ unsigned xb_add(unsigned* p, unsigned v) { return __hip_atomic_fetch_add(p, v, __ATOMIC_RELAXED, __HIP_MEMORY_SCOPE_AGENT); }
__device__ __forceinline__ unsigned xb_xcc_id() { return (unsigned)__builtin_amdgcn_s_getreg((3 << 11) | 20) & 0xFu; }
#define XB_SPIN(cond, bar) do { unsigned _sp = 0; while (cond) { __builtin_amdgcn_s_sleep(1); \
    if ((++_sp & 255u) == 0u) { if (xb_ld(&(bar)[XB_TMO])) break; if (_sp > XB_SPIN_CAP) { atomicAdd(&(bar)[XB_TMO], 1u); break; } } } } while (0)
struct XcdBarrier { unsigned* bar; unsigned x; volatile LAS unsigned* st; };
__device__ __forceinline__ XcdBarrier xcd_barrier_post(unsigned* bar, volatile LAS unsigned* st) {
    XcdBarrier b; b.bar = bar; b.x = xb_xcc_id(); b.st = st;
    if (threadIdx.x == 0) (void)xb_add(&bar[XB_XCNT(b.x)], 1u);
    return b;
}
__device__ __forceinline__ void xcd_barrier_complete(unsigned* bar, unsigned x, unsigned& nloc, unsigned& nx) {
    const unsigned G = gridDim.x * gridDim.y * gridDim.z;
    unsigned sum, cnt, mine, sp = 0u;
    for (;;) {
        sum = 0u; cnt = 0u; mine = 0u;
#pragma unroll
        for (unsigned j = 0; j < 16; ++j) { const unsigned c = xb_ld(&bar[XB_XCNT(j)]); sum += c; cnt += (c > 0u) ? 1u : 0u; mine = (j == x) ? c : mine; }
        if (sum == G) break;
        __builtin_amdgcn_s_sleep(1);
        if ((++sp & 255u) == 0u) { if (xb_ld(&bar[XB_TMO])) break; if (sp > XB_SPIN_CAP) { atomicAdd(&bar[XB_TMO], 1u); break; } }
    }
    nloc = mine > 0u ? mine : 1u; nx = cnt > 0u ? cnt : 1u;
}
__device__ __forceinline__ void xcd_barrier(const XcdBarrier& b) {
    asm volatile("s_waitcnt vmcnt(0)" ::: "memory");
    __syncthreads();
    if (threadIdx.x == 0) {
        unsigned* bar = b.bar;
        __builtin_amdgcn_s_waitcnt(0);
        unsigned nloc = b.st[0], nx = b.st[1];
        if (nloc == 0u) { xcd_barrier_complete(bar, b.x, nloc, nx); b.st[0] = nloc; b.st[1] = nx; }
        const unsigned old = xb_add(&bar[XB_XSUB(b.x)], 1u);
        const unsigned gen = old / nloc;
        if (old + 1u == (gen + 1u) * nloc) {
            __builtin_amdgcn_fence(__ATOMIC_RELEASE, "agent");
            asm volatile("s_waitcnt vmcnt(0)" ::: "memory");
            const unsigned og = xb_add(&bar[XB_TOP], 1u);
            const unsigned tg = og / nx;
            if (og + 1u == (tg + 1u) * nx) xb_add(&bar[XB_TOPGEN], 1u);
            else XB_SPIN(xb_ld(&bar[XB_TOPGEN]) == tg, bar);
            __builtin_amdgcn_fence(__ATOMIC_ACQUIRE, "agent");
            xb_add(&bar[XB_XGEN(b.x)], 1u);
            asm volatile("s_waitcnt vmcnt(0)" ::: "memory");
        } else {
            XB_SPIN(xb_ld(&bar[XB_XGEN(b.x)]) == gen, bar);
            __builtin_amdgcn_fence(__ATOMIC_ACQUIRE, "agent");
            asm volatile("s_waitcnt vmcnt(0)" ::: "memory");
        }
    }
    __syncthreads();
}

constexpr int NWAVES = 8, NTHREADS = 512;
constexpr int LDS_BYTES = 147456;
struct Args { const float* in[19]; float* out; unsigned char* ws; int ph_lo, ph_hi; };

__device__ __forceinline__ void p0_transpose_item(const float* W, int K, int Nsrc, int srccol  , bf16_t* WT, int r0d, const float* ksc, LAS float* scr, int kb, int lane) {
    const int k0 = 64 * kb, nq = lane & 7, kr = lane >> 3;
    f32x4 v[8]; float sc[8];
#pragma unroll
    for (int j = 0; j < 8; ++j) { v[j] = __builtin_nontemporal_load((const f32x4*)(W + (size_t)(k0 + 8 * j + kr) * Nsrc + srccol)); sc[j] = ksc ? ksc[k0 + 8 * j + kr] : 1.0f; }
#pragma unroll
    for (int j = 0; j < 8; ++j) { LAS float* d = scr + (8 * j + kr) * 33 + 4 * nq; d[0] = v[j][0] * sc[j]; d[1] = v[j][1] * sc[j]; d[2] = v[j][2] * sc[j]; d[3] = v[j][3] * sc[j]; }
    asm volatile("s_waitcnt lgkmcnt(0)" ::: "memory");
    const int c = lane & 7;
#pragma unroll
    for (int j = 0; j < 4; ++j) { const int n = (lane >> 3) + 8 * j; const LAS float* s = scr + (8 * c) * 33 + n;
        u32x4 o; o.x = cvt_pk_bf16(s[0 * 33], s[1 * 33]); o.y = cvt_pk_bf16(s[2 * 33], s[3 * 33]); o.z = cvt_pk_bf16(s[4 * 33], s[5 * 33]); o.w = cvt_pk_bf16(s[6 * 33], s[7 * 33]);
        *(u32x4*)(WT + (size_t)(r0d + n) * K + k0 + 8 * c) = o; }
    asm volatile("s_waitcnt lgkmcnt(0)" ::: "memory");
}
__device__ __forceinline__ int w1_src_col(int r) {
    const int pn = r >> 8, j = r & 255;
    if (pn < 8)  return ((j >> 7) ? 2 : 0) * 1024 + 128 * pn + (j & 127);
    if (pn < 24) { const int bj = j >> 7, n = (j >> 2) & 1, wc = (j >> 5) & 3, fq = (j >> 3) & 3; const int sec = bj ? (n ? 6 : 4) : (n ? 5 : 3); return sec * 1024 + 64 * (pn - 8) + 16 * wc + 4 * fq; }
    if (pn < 28) return 1 * 1024 + 256 * (pn - 24) + j;
    if (pn < 32) return 7 * 1024 + 256 * (pn - 28) + j;
    return 8 * 1024 + 256 * (pn - 32) + j;
}

__global__ void __launch_bounds__(NTHREADS, 2) mk_fwd(Args args) {
    extern __shared__ __attribute__((aligned(16))) unsigned char lds_raw[];
    LAS unsigned char* lds = (LAS unsigned char*)lds_raw;
    cg::grid_group grid = cg::this_grid();
    const int tid = threadIdx.x, lane = tid & 63, wave = __builtin_amdgcn_readfirstlane(tid >> 6);
    const int G = gridDim.x, bx = blockIdx.x;
    const int gw = bx * NWAVES + wave, NGW = G * NWAVES;
    unsigned char* ws = args.ws; float* out = args.out;
    const float *x_p = args.in[0], *x_s = args.in[1], *state_conv = args.in[2], *p_p = args.in[3], *p_s = args.in[4], *norm_g = args.in[5], *w_in = args.in[6],
                *ln_g = args.in[7], *ln_b = args.in[8], *w_s = args.in[9], *b_s = args.in[10], *conv_w = args.in[11], *w_a = args.in[12], *w_b = args.in[13], *w_o = args.in[14],
                *pe_g = args.in[15], *w_pg = args.in[16], *w_pp = args.in[17], *fin_g = args.in[18];
    bf16_t *W1 = (bf16_t*)(ws + WS_W1), *W2 = (bf16_t*)(ws + WS_W2), *W3 = (bf16_t*)(ws + WS_W3), *W4 = (bf16_t*)(ws + WS_W4), *W5 = (bf16_t*)(ws + WS_W5), *WS = (bf16_t*)(ws + WS_WS);
    bf16_t* PBIN = (bf16_t*)(ws + WS_PB);
    float* INV = (float*)(ws + WS_INV);
    f32x2* VST = (f32x2*)(ws + WS_VST); float* ST1 = (float*)(ws + WS_ST1); float* ST2 = (float*)(ws + WS_ST2);
    bf16_t *S0 = (bf16_t*)(ws + WS_S0), *S1 = (bf16_t*)(ws + WS_S0 + U), *S2 = (bf16_t*)(ws + WS_S0 + 2 * U), *S3 = (bf16_t*)(ws + WS_S0 + 3 * U), *S4 = (bf16_t*)(ws + WS_S0 + 4 * U), *S5 = (bf16_t*)(ws + WS_S0 + 5 * U);
    bf16_t *XB = S1, *YA = S0, *UG = S2, *YB = S3, *SMB = S4, *VG = S5, *MG = S2, *X1B = S0, *X2B = S4;
    unsigned char *SAq = (unsigned char*)out, *SBq = (unsigned char*)out + (size_t)M * D;
    bf16_t* PBUF = (bf16_t*)((unsigned char*)out + 2 * (size_t)M * D);
    const int lo = args.ph_lo, hi = args.ph_hi;
#define IN(k) (lo <= (k) && (k) < hi)
    if (tid < 16) ((LAS unsigned*)(lds + 131072 + 64))[tid] = 0u;
    __syncthreads();
    const XcdBarrier bar = xcd_barrier_post((unsigned*)(ws + WS_CTL), (volatile LAS unsigned*)(lds + 131072 + 64));
    if (hi > 1000) grid.sync();
#define GRID_BAR() xcd_barrier(bar)
#define SEAM(k) do { if (IN(k) && IN((k) + 1)) { GRID_BAR(); if (MK_REPEAT == 11) GRID_BAR(); } } while (0)

    if (IN(0)) for (int rep = 0; rep < (MK_REPEAT == 0 ? 2 : 1); ++rep) { if (rep) GRID_BAR();
        LAS float* scr = (LAS float*)(lds + wave * 16384);
        constexpr int I1 = 16 * 288, I5 = 4 * 32;
        constexpr int NITEMS = I1 + I5;
        for (int it = gw; it < NITEMS; it += NGW) {
            int r = it;
            if (r < I1) { const int kb = r / 288, nb = r % 288; p0_transpose_item(w_in, 1024, NIN, w1_src_col(nb * 32 + 4 * (lane & 7)), W1, nb * 32, norm_g, scr, kb, lane); continue; } r -= I1;
            p0_transpose_item(w_pp, 256, 1024, (r % 32) * 32 + 4 * (lane & 7), W5, (r % 32) * 32, nullptr, scr, r / 32, lane);
        }
        for (int t = 0; ; ++t) {
            int m0;
            if (G == 256) { if (t < 4) m0 = 2048 * (bx & 7) + 64 * (bx >> 3) + 8 * wave + 2 * t; else if (t == 4 && wave == 0) m0 = NPROMPT + 2 * bx; else break; }
            else { m0 = 2 * gw + 2 * NGW * t; if (m0 >= M) break; }
            f32x4 v[2][4], pv[2]; float ssum[2];
#pragma unroll
            for (int r = 0; r < 2; ++r) {
                const int m = m0 + r;
                const float* xr = m < NPROMPT ? x_p + (size_t)m * D : x_s + (size_t)(m - NPROMPT) * D;
                const float* pr = m < NPROMPT ? p_p + (size_t)m * PD : p_s + (size_t)(m - NPROMPT) * PD;
#pragma unroll
                for (int j = 0; j < 4; ++j) v[r][j] = __builtin_nontemporal_load((const f32x4*)(xr + 4 * lane + 256 * j));
                pv[r] = __builtin_nontemporal_load((const f32x4*)(pr + 4 * lane));
            }
#pragma unroll
            for (int r = 0; r < 2; ++r) { float q = 0.f;
#pragma unroll
                for (int j = 0; j < 4; ++j) q += (v[r][j][0] * v[r][j][0] + v[r][j][1] * v[r][j][1]) + (v[r][j][2] * v[r][j][2] + v[r][j][3] * v[r][j][3]);
                ssum[r] = q; }
#pragma unroll
            for (int o = 1; o < 64; o <<= 1) { ssum[0] += __shfl_xor(ssum[0], o); ssum[1] += __shfl_xor(ssum[1], o); }
#pragma unroll
            for (int r = 0; r < 2; ++r) {
                const int m = m0 + r; const float rstd = __builtin_amdgcn_rsqf(ssum[r] * (1.0f / D) + EPS);
                if (lane == 0) INV[m] = __builtin_amdgcn_rcpf(rstd);
#pragma unroll
                for (int j = 0; j < 4; ++j) *(u32x2*)(XB + (size_t)m * D + 4 * lane + 256 * j) = (u32x2){cvt_pk_bf16(v[r][j][0] * rstd, v[r][j][1] * rstd), cvt_pk_bf16(v[r][j][2] * rstd, v[r][j][3] * rstd)};
                *(u32x2*)(PBIN + (size_t)m * PD + 4 * lane) = (u32x2){cvt_pk_bf16(pv[r][0], pv[r][1]), cvt_pk_bf16(pv[r][2], pv[r][3])};
            }
        }
    }
    SEAM(0);
    if (MK_REPEAT == 8) { GRID_BAR(); GRID_BAR(); GRID_BAR(); GRID_BAR(); }

    if (IN(1)) {
        for (int rep = 0; rep < (MK_REPEAT == 1 ? 2 : 1); ++rep) {
        pg8::Gemm g{XB, W1, M, NIN, D}; pg8::P1Order S; S.init(G, bx);
        Epi1 E{UG, VG, SMB, SAq, VST, out, conv_w};
        pg8::gemm_phase<Epi1, pg8::P1Order, true, true>(lds, g, S, E); }
        { pg8::Gemm g2{PBIN, W5, NPROMPT, D, PD}; pg8::SlackOrder S2; S2.init(G, bx, ((M / 256) * (NIN / 256)) % G);
          EpiP E2{PBUF};
          pg8::gemm_phase<EpiP, pg8::SlackOrder, true, true>(lds, g2, S2, E2); }
        {
            const int first = ((M / 256) * (NIN / 256)) % G, ns = (first > 0 ? G - first : G), c2 = (first > 0 ? bx - first : bx);
            LAS float* scr = (LAS float*)(lds + wave * 16384);
            constexpr int I2 = 16 * 32;
            if (c2 >= 0) for (int it = c2 * NWAVES + wave; it < 4 * I2 + 256; it += ns * NWAVES) {
                int r = it;
                if (r < I2) { p0_transpose_item(w_a, 1024, 1024, (r % 32) * 32 + 4 * (lane & 7), W2, (r % 32) * 32, nullptr, scr, r / 32, lane); continue; } r -= I2;
                if (r < I2) { p0_transpose_item(w_b, 1024, 1024, (r % 32) * 32 + 4 * (lane & 7), W2, 1024 + (r % 32) * 32, nullptr, scr, r / 32, lane); continue; } r -= I2;
                if (r < I2) { p0_transpose_item(w_o, 1024, 1024, (r % 32) * 32 + 4 * (lane & 7), W3, (r % 32) * 32, nullptr, scr, r / 32, lane); continue; } r -= I2;
                if (r < I2) { p0_transpose_item(w_pg, 1024, 1024, (r % 32) * 32 + 4 * (lane & 7), W4, (r % 32) * 32, pe_g, scr, r / 32, lane); continue; } r -= I2;
                const int e0 = r * 512 + lane * 8; const int s0 = e0 & 127, t = (e0 >> 7) & 127;
                const f32x4 a = *(const f32x4*)(w_s + e0), b = *(const f32x4*)(w_s + e0 + 4);
                float v[8] = {a[0], a[1], a[2], a[3], b[0], b[1], b[2], b[3]};
#pragma unroll
                for (int i = 0; i < 8; ++i) if (s0 + i > t) v[i] = 0.f;
                *(u32x4*)(WS + e0) = PACK8(v);
            }
        }
    }
    SEAM(1);

    if (IN(2)) for (int rep = 0; rep < (MK_REPEAT == 2 ? 2 : 1); ++rep) { if (rep) GRID_BAR();
        constexpr int NMIX = 512;
        LAS float* ST2L = (LAS float*)(lds + 67584);
        LAS float* ST = ST2L;
        for (int it = 0; ; ++it) {
            int unit;
            if (G == 256) { const int xq = bx & 7, jq = bx >> 3;
                if (it < 2) unit = 64 * xq + jq + 32 * it; else if (it == 2) unit = NMIX + 128 + 32 * xq + jq; else if (it == 3 && bx < 128) unit = NMIX + bx; else break; }
            else { unit = bx + it * G; if (unit >= NMIX + 128 + 256) break; }
            if (unit >= NMIX + 128) {
                const int k = unit - (NMIX + 128), rr = tid >> 8, col = 4 * (tid & 255);
                const bool hist = ((k * 64) & 2047) != 0;
                const u32x2 bgw = *(const u32x2*)(SMB + SM_BGF + (size_t)(k * 2 + rr) * 1024 + col);
                const u32x2 cf0 = *(const u32x2*)(SMB + SM_CHF + (size_t)(k * 2 + 0) * 1024 + col), cf1 = *(const u32x2*)(SMB + SM_CHF + (size_t)(k * 2 + 1) * 1024 + col);
                u32x2 cl0 = (u32x2){0u, 0u}, cl1 = (u32x2){0u, 0u};
                if (hist) { cl0 = *(const u32x2*)(SMB + SM_CHL + (size_t)((k - 1) * 2 + 0) * 1024 + col); cl1 = *(const u32x2*)(SMB + SM_CHL + (size_t)((k - 1) * 2 + 1) * 1024 + col); }
                const f32x4 w0 = *(const f32x4*)(conv_w + col), w1 = *(const f32x4*)(conv_w + 1024 + col), w2 = *(const f32x4*)(conv_w + 2048 + col);
                const u32x2 a2 = rr ? cl1 : cl0, a1 = rr ? cf0 : cl1, a0 = rr ? cf1 : cf0;
                f32x4 y;
                y[0] = bflo(bgw[0]) * (w0[0] * bflo(a2[0]) + w1[0] * bflo(a1[0]) + w2[0] * bflo(a0[0])); y[1] = bfhi(bgw[0]) * (w0[1] * bfhi(a2[0]) + w1[1] * bfhi(a1[0]) + w2[1] * bfhi(a0[0]));
                y[2] = bflo(bgw[1]) * (w0[2] * bflo(a2[1]) + w1[2] * bflo(a1[1]) + w2[2] * bflo(a0[1])); y[3] = bfhi(bgw[1]) * (w0[3] * bfhi(a2[1]) + w1[3] * bfhi(a1[1]) + w2[3] * bfhi(a0[1]));
                *(u32x2*)(YB + (size_t)(k * 64 + rr) * 1024 + col) = (u32x2){cvt_pk_bf16(y[0], y[1]), cvt_pk_bf16(y[2], y[3])};
            } else if (unit < NMIX) {
                const int c = unit >> 2, hp = unit & 3, R0 = c * 128;
                const int cch = tid & 31, rg = tid >> 5, dch = hp * 256 + cch * 8;
                const int hh = wave >> 2, tb = wave & 3, fr = lane & 15, g4 = lane >> 4;
                const int h = hp * 2 + hh;
                f32x2 stv[4];
#pragma unroll
                for (int j = 0; j < 4; ++j) stv[j] = VST[(size_t)(R0 + (tid >> 2)) * 16 + 4 * (tid & 3) + j];
                u32x4 vw[8];
#pragma unroll
                for (int j = 0; j < 8; ++j) vw[j] = __builtin_nontemporal_load((const u32x4*)(VG + (size_t)(R0 + rg + 16 * j) * 1024 + dch));
                const f32x4 g0 = *(const f32x4*)(ln_g + dch), g1 = *(const f32x4*)(ln_g + dch + 4), b0 = *(const f32x4*)(ln_b + dch), b1 = *(const f32x4*)(ln_b + dch + 4);
                const bf16_t* Wh = WS + (size_t)h * 16384;
                u32x2 bWl[4][2], bWh[4][2];
#pragma unroll
                for (int ks = 0; ks < 4; ++ks)
                    if (ks <= tb) {
#pragma unroll
                        for (int n = 0; n < 2; ++n) { const bf16_t* wp = Wh + (size_t)(32 * tb + 16 * n + fr) * 128 + 32 * ks + 4 * g4; bWl[ks][n] = *(const u32x2*)wp; bWh[ks][n] = *(const u32x2*)(wp + 16); }
                    }
                {
                    float s = (stv[0][0] + stv[1][0]) + (stv[2][0] + stv[3][0]), ss = (stv[0][1] + stv[1][1]) + (stv[2][1] + stv[3][1]);
                    s += __shfl_xor(s, 1); ss += __shfl_xor(ss, 1); s += __shfl_xor(s, 2); ss += __shfl_xor(ss, 2);
                    const float mean = s * (1.0f / 1024.0f), var = fmaxf(ss * (1.0f / 1024.0f) - mean * mean, 0.f);
                    if ((tid & 3) == 0) { ST2L[2 * (tid >> 2)] = mean; ST2L[2 * (tid >> 2) + 1] = __builtin_amdgcn_rsqf(var + LN_EPS); }
                }
                __syncthreads();
                u32x4 uw[2][4]; float bsv[2];
#pragma unroll
                for (int n = 0; n < 2; ++n) {
                    const int t = 32 * tb + 16 * n + fr; bsv[n] = b_s[h * 128 + t];
                    const size_t off = (size_t)(R0 + t) * 1024 + h * 128 + 32 * g4;
#pragma unroll
                    for (int k = 0; k < 4; ++k) uw[n][k] = __builtin_nontemporal_load((const u32x4*)(UG + off + 8 * k));
                }
                {
                    const bool lastc = (c & 15) == 15; const int bidx = c >> 4;
                    LAS unsigned char* img = lds + (cch >> 4) * 33792 + (cch & 15) * 16;
#pragma unroll
                    for (int j = 0; j < 8; ++j) {
                        const int sI = rg + 16 * j; float v[8]; UNPACK8(vw[j], v);
                        const float mean = ST2L[2 * sI], rstd = ST2L[2 * sI + 1];
#pragma unroll
                        for (int i = 0; i < 4; ++i) { v[i] = (v[i] - mean) * rstd * g0[i] + b0[i]; v[4 + i] = (v[4 + i] - mean) * rstd * g1[i] + b1[i]; }
                        if (lastc) { float* o = out + O_VP + (size_t)(bidx * 128 + sI) * 1024 + dch; *(f32x4*)o = (f32x4){v[0], v[1], v[2], v[3]}; *(f32x4*)(o + 4) = (f32x4){v[4], v[5], v[6], v[7]}; }
                        *(LAS u32x2*)(img + sI * 264) = (u32x2){cvt_pk_bf16(v[0], v[1]), cvt_pk_bf16(v[2], v[3])};
                        *(LAS u32x2*)(img + sI * 264 + 8) = (u32x2){cvt_pk_bf16(v[4], v[5]), cvt_pk_bf16(v[6], v[7])};
                    }
                }
                __syncthreads();
                {
                    f32x4 acc[8][2];
#pragma unroll
                    for (int a2 = 0; a2 < 8; ++a2)
#pragma unroll
                        for (int b2 = 0; b2 < 2; ++b2) acc[a2][b2] = (f32x4){0.f, 0.f, 0.f, 0.f};
                    const LAS unsigned char* tra = lds + hh * 33792 + (4 * g4 + ((lane & 15) >> 2)) * 264 + (lane & 3) * 64;
#pragma unroll
                    for (int ks = 0; ks < 4; ++ks)
                        if (ks <= tb) {
                            bf16x8 bW[2];
#pragma unroll
                            for (int n = 0; n < 2; ++n) bW[n] = __builtin_bit_cast(bf16x8, (u32x4){bWl[ks][n][0], bWl[ks][n][1], bWh[ks][n][0], bWh[ks][n][1]});
#pragma unroll
                            for (int d = 0; d < 8; ++d) {
                                const v4i16_t lo = __builtin_amdgcn_ds_read_tr16_b64_v4i16((LAS v4i16_t*)(tra + (32 * ks) * 264 + 8 * d));
                                const v4i16_t hi2 = __builtin_amdgcn_ds_read_tr16_b64_v4i16((LAS v4i16_t*)(tra + (32 * ks + 16) * 264 + 8 * d));
                                const bf16x8 aV = (bf16x8){lo[0], lo[1], lo[2], lo[3], hi2[0], hi2[1], hi2[2], hi2[3]};
#pragma unroll
                                for (int n = 0; n < 2; ++n) acc[d][n] = __builtin_amdgcn_mfma_f32_16x16x32_bf16(aV, bW[n], acc[d][n], 0, 0, 0);
                            }
                        }
#pragma unroll
                    for (int n = 0; n < 2; ++n) {
                        const int t = 32 * tb + 16 * n + fr;
                        const size_t off = (size_t)(R0 + t) * 1024 + h * 128 + 32 * g4;
#pragma unroll
                        for (int k = 0; k < 4; ++k) {
                            float ug[8], o[8]; UNPACK8(uw[n][k], ug);
#pragma unroll
                            for (int i = 0; i < 4; ++i) { o[i] = ug[i] * (acc[2 * k][n][i] + bsv[n]); o[4 + i] = ug[4 + i] * (acc[2 * k + 1][n][i] + bsv[n]); }
                            *(u32x4*)(YA + off + 8 * k) = PACK8(o);
                        }
                    }
                }
                __syncthreads();
            } else {
                const int b = unit - NMIX, R0 = NPROMPT + 4 * b;
                if (tid < 4) {
                    const f32x2* vs = VST + (size_t)(R0 + tid) * 16; float s = 0.f, ss = 0.f;
#pragma unroll
                    for (int j = 0; j < 16; ++j) { const f32x2 v = vs[j]; s += v[0]; ss += v[1]; }
                    const float mean = s * (1.0f / 1024.0f), var = fmaxf(ss * (1.0f / 1024.0f) - mean * mean, 0.f);
                    ST[2 * tid] = mean; ST[2 * tid + 1] = __builtin_amdgcn_rsqf(var + LN_EPS);
                }
                __syncthreads();
                {
                    const int ch = 2 * tid, h = ch >> 7;
                    const f32x2 g2 = *(const f32x2*)(ln_g + ch), b2 = *(const f32x2*)(ln_b + ch);
                    float vn[4][2];
#pragma unroll
                    for (int t = 0; t < 4; ++t) {
                        const unsigned w = *(const unsigned*)(VG + (size_t)(R0 + t) * 1024 + ch);
                        const float mean = ST[2 * t], rstd = ST[2 * t + 1];
                        vn[t][0] = (bflo(w) - mean) * rstd * g2[0] + b2[0]; vn[t][1] = (bfhi(w) - mean) * rstd * g2[1] + b2[1];
                        *(f32x2*)(out + O_VS + (size_t)(b * 4 + t) * 1024 + ch) = (f32x2){vn[t][0], vn[t][1]};
                    }
                    const f32x2 c0 = *(const f32x2*)(conv_w + ch), c1 = *(const f32x2*)(conv_w + 1024 + ch), c2 = *(const f32x2*)(conv_w + 2048 + ch);
                    f32x2 q2 = *(const f32x2*)(state_conv + (size_t)(b * 2 + 0) * 1024 + ch), q1 = *(const f32x2*)(state_conv + (size_t)(b * 2 + 1) * 1024 + ch);
#pragma unroll
                    for (int t = 0; t < 4; ++t) {
                        const size_t off = (size_t)(R0 + t) * 1024 + ch;
                        float s0 = b_s[h * 128 + t], s1 = s0;
#pragma unroll
                        for (int s = 0; s <= t; ++s) { const float wv = w_s[(size_t)h * 16384 + t * 128 + s]; s0 += wv * vn[s][0]; s1 += wv * vn[s][1]; }
                        const size_t so = (size_t)(4 * b + t) * 1024 + ch;
                        const unsigned uw = *(const unsigned*)(UG + off), cw = *(const unsigned*)(SMB + SM_CHS + so), bw = *(const unsigned*)(SMB + SM_BGS + so);
                        *(unsigned*)(YA + off) = cvt_pk_bf16(bflo(uw) * s0, bfhi(uw) * s1);
                        const f32x2 cu = (f32x2){bflo(cw), bfhi(cw)};
                        *(unsigned*)(YB + off) = cvt_pk_bf16(bflo(bw) * (c0[0] * q2[0] + c1[0] * q1[0] + c2[0] * cu[0]), bfhi(bw) * (c0[1] * q2[1] + c1[1] * q1[1] + c2[1] * cu[1]));
                        q2 = q1; q1 = cu;
                    }
                }
                __syncthreads();
            }
        }
    }
    SEAM(2);

    if (IN(3)) {
        for (int rep = 0; rep < (MK_REPEAT == 3 ? 2 : 1); ++rep)
        { pg8::Gemm g{YA, W2, NPROMPT, D, D}; pg8::PairOrder S; S.init(NPROMPT, D, G, bx, 3 * M);
          Epi2 E{SAq, SBq, MG};
          pg8::gemm_phase<Epi2, pg8::PairOrder, true, true>(lds, g, S, E); }
        for (int c = bx; c < 256; c += G) {
            const int r0 = NPROMPT + 32 * (c >> 4), c0 = 64 * (c & 15);
            const f32x4 pa = thin_gemm_s(lds, YA + (size_t)r0 * D, W2 + (size_t)c0 * D, wave, lane, tid);
            const f32x4 pb = thin_gemm_s(lds, YB + (size_t)r0 * D, W2 + (size_t)(1024 + c0) * D, wave, lane, tid);
            const size_t off = (size_t)(r0 + (tid >> 4)) * D + c0 + 4 * (tid & 15);
            const unsigned wa = *(const unsigned*)(SAq + off), wb = *(const unsigned*)(SBq + off); const float k = 1.0f / 255.0f;
            *(u32x2*)(MG + off) = (u32x2){cvt_pk_bf16(((float)(wa & 255u) * pa[0] + (float)(wb & 255u) * pb[0]) * k, ((float)((wa >> 8) & 255u) * pa[1] + (float)((wb >> 8) & 255u) * pb[1]) * k),
                                          cvt_pk_bf16(((float)((wa >> 16) & 255u) * pa[2] + (float)((wb >> 16) & 255u) * pb[2]) * k, ((float)(wa >> 24) * pa[3] + (float)(wb >> 24) * pb[3]) * k)};
        }
    }
    SEAM(3);

    if (IN(4)) for (int rep = 0; rep < (MK_REPEAT == 4 ? 2 : 1); ++rep) { if (rep) GRID_BAR();
        { pg8::Gemm g{MG, W3, NPROMPT, D, D}; pg8::StaticOrder S; S.init(NPROMPT, D, G, bx);
          Epi3 E{XB, INV, X1B, ST1};
          pg8::gemm_phase<Epi3, pg8::StaticOrder, true, true>(lds, g, S, E); }
        for (int c = bx; c < 256; c += G) {
            const int r0 = NPROMPT + 32 * (c >> 4), c0 = 64 * (c & 15), row = r0 + (tid >> 4), col = c0 + 4 * (tid & 15);
            const f32x4 xv = *(const f32x4*)(x_s + (size_t)(row - NPROMPT) * D + col);
            const f32x4 v = xv + thin_gemm_s(lds, MG + (size_t)r0 * D, W3 + (size_t)c0 * D, wave, lane, tid);
            *(u32x2*)(X1B + (size_t)row * D + col) = (u32x2){cvt_pk_bf16(v[0], v[1]), cvt_pk_bf16(v[2], v[3])};
            float ss = (v[0] * v[0] + v[1] * v[1]) + (v[2] * v[2] + v[3] * v[3]);
            ss += __shfl_xor(ss, 1); ss += __shfl_xor(ss, 2); ss += __shfl_xor(ss, 4); ss += __shfl_xor(ss, 8);
            if ((tid & 15) == 0) ST1[(size_t)row * 16 + (c & 15)] = ss;
        }
    }
    SEAM(4);

    if (IN(5)) for (int rep = 0; rep < (MK_REPEAT == 5 ? 2 : 1); ++rep) { if (rep) GRID_BAR();
        { pg8::Gemm g{X1B, W4, NPROMPT, D, D}; pg8::StaticOrder S; S.init(NPROMPT, D, G, bx);
          Epi4 E{X1B, PBUF, ST1, X2B, ST2};
          pg8::gemm_phase<Epi4, pg8::StaticOrder, true, true>(lds, g, S, E); }
        for (int c = bx; c < 256; c += G) {
            const int r0 = NPROMPT + 32 * (c >> 4), c0 = 64 * (c & 15), row = r0 + (tid >> 4), col = c0 + 4 * (tid & 15);
            const u32x2 xw = *(const u32x2*)(X1B + (size_t)row * D + col);
            float s1 = ST1[(size_t)row * 16 + (tid & 15)];
            s1 += __shfl_xor(s1, 1); s1 += __shfl_xor(s1, 2); s1 += __shfl_xor(s1, 4); s1 += __shfl_xor(s1, 8);
            const float rstd = __builtin_amdgcn_rsqf(s1 * (1.0f / 1024.0f) + EPS);
            const f32x4 gq = thin_gemm_s(lds, X1B + (size_t)r0 * D, W4 + (size_t)c0 * D, wave, lane, tid);
            const f32x4 pq = thin_gemm<256>(lds, PBIN + (size_t)r0 * PD, W5 + (size_t)c0 * PD, wave, lane, tid);
            f32x4 v;
            v[0] = bflo(xw[0]) + fsigmoid(rstd * gq[0]) * pq[0]; v[1] = bfhi(xw[0]) + fsigmoid(rstd * gq[1]) * pq[1];
            v[2] = bflo(xw[1]) + fsigmoid(rstd * gq[2]) * pq[2]; v[3] = bfhi(xw[1]) + fsigmoid(rstd * gq[3]) * pq[3];
            *(u32x2*)(X2B + (size_t)row * D + col) = (u32x2){cvt_pk_bf16(v[0], v[1]), cvt_pk_bf16(v[2], v[3])};
            float ss = (v[0] * v[0] + v[1] * v[1]) + (v[2] * v[2] + v[3] * v[3]);
            ss += __shfl_xor(ss, 1); ss += __shfl_xor(ss, 2); ss += __shfl_xor(ss, 4); ss += __shfl_xor(ss, 8);
            if ((tid & 15) == 0) ST2[(size_t)row * 16 + (c & 15)] = ss;
        }
    }
    SEAM(5);

    if (IN(6)) {
        f32x4 gv[4];
#pragma unroll
        for (int j = 0; j < 4; ++j) gv[j] = *(const f32x4*)(fin_g + 4 * lane + 256 * j);
        if (G == 256) {
            const int mb = 2048 * (bx & 7) + 64 * (bx >> 3) + 8 * wave;
            u32x2 xw[8][4]; float p[8];
#pragma unroll
            for (int r = 0; r < 8; ++r) {
#pragma unroll
                for (int j = 0; j < 4; ++j) xw[r][j] = __builtin_nontemporal_load((const u32x2*)(X2B + (size_t)(mb + r) * D + 4 * lane + 256 * j));
                p[r] = lane < 16 ? ST2[(size_t)(mb + r) * 16 + lane] : 0.f;
            }
#pragma unroll
            for (int o = 1; o < 16; o <<= 1) {
#pragma unroll
                for (int r = 0; r < 8; ++r) p[r] += __shfl_xor(p[r], o);
            }
#pragma unroll
            for (int r = 0; r < 8; ++r) {
                const float rstd = __builtin_amdgcn_rsqf(__shfl(p[r], 0) * (1.0f / D) + EPS);
                float* xr = out + (size_t)(mb + r) * D;
#pragma unroll
                for (int j = 0; j < 4; ++j) __builtin_nontemporal_store((f32x4){bflo(xw[r][j][0]), bfhi(xw[r][j][0]), bflo(xw[r][j][1]), bfhi(xw[r][j][1])} * rstd * gv[j], (f32x4*)(xr + 4 * lane + 256 * j));
            }
        }
        for (int t = (G == 256 ? 4 : 0); ; ++t) {
            int m0;
            if (G == 256) { if (t == 4 && wave == 0) m0 = NPROMPT + 2 * bx; else break; }
            else { m0 = 2 * gw + 2 * NGW * t; if (m0 >= M) break; }
            u32x2 xw[2][4]; float p[2];
#pragma unroll
            for (int r = 0; r < 2; ++r) {
#pragma unroll
                for (int j = 0; j < 4; ++j) xw[r][j] = __builtin_nontemporal_load((const u32x2*)(X2B + (size_t)(m0 + r) * D + 4 * lane + 256 * j));
                p[r] = lane < 16 ? ST2[(size_t)(m0 + r) * 16 + lane] : 0.f;
            }
#pragma unroll
            for (int o = 1; o < 16; o <<= 1) { p[0] += __shfl_xor(p[0], o); p[1] += __shfl_xor(p[1], o); }
#pragma unroll
            for (int r = 0; r < 2; ++r) {
                const float rstd = __builtin_amdgcn_rsqf(__shfl(p[r], 0) * (1.0f / D) + EPS);
                float* xr = out + (size_t)(m0 + r) * D;
#pragma unroll
                for (int j = 0; j < 4; ++j) __builtin_nontemporal_store((f32x4){bflo(xw[r][j][0]), bfhi(xw[r][j][0]), bflo(xw[r][j][1]), bfhi(xw[r][j][1])} * rstd * gv[j], (f32x4*)(xr + 4 * lane + 256 * j));
            }
        }
    }
    if (MK_REPEAT == 107 && IN(7)) {
        pg8::Gemm g{XB, W1, M, NIN, D}; pg8::StaticOrder S; S.init(M, NIN, G, bx);
        EpiRaw E{S0};
        pg8::gemm_phase<EpiRaw, pg8::StaticOrder, true, true>(lds, g, S, E);
    }
#undef IN
#undef SEAM
}

extern "C" void kernel_launch(void* const* d_in, const int* in_sizes, int n_in, void* d_out, int out_size, void* d_ws, size_t ws_size, hipStream_t stream) {
    static int grid = 0;
    if (grid == 0) {
        if (n_in != 19 || ws_size < WS_END) { fprintf(stderr, "kernel_launch: unexpected problem (n_in %d, ws %zu < %zu)\n", n_in, ws_size, (size_t)WS_END); grid = -1; return; }
        int dev = 0, cus = 0, per_cu = 0;
        (void)hipGetDevice(&dev);
        (void)hipDeviceGetAttribute(&cus, hipDeviceAttributeMultiprocessorCount, dev);
        if (hipFuncSetAttribute((const void*)mk_fwd, hipFuncAttributeMaxDynamicSharedMemorySize, LDS_BYTES) != hipSuccess) { fprintf(stderr, "kernel_launch: hipFuncSetAttribute failed\n"); grid = -1; return; }
        if (hipOccupancyMaxActiveBlocksPerMultiprocessor(&per_cu, (const void*)mk_fwd, NTHREADS, LDS_BYTES) != hipSuccess || per_cu < 1) { fprintf(stderr, "kernel_launch: occupancy query says %d\n", per_cu); per_cu = 1; }
        (void)hipGetLastError();
        grid = cus * per_cu;
        if (grid <= 0) grid = 256;
    }
    if (grid < 0) return;
    (void)hipMemsetAsync((unsigned char*)d_ws + WS_CTL, 0, CTL_BYTES, stream);
    if (MK_REPEAT == 12) { (void)hipMemsetAsync((unsigned char*)d_ws + WS_CTL, 0, CTL_BYTES, stream); (void)hipMemsetAsync((unsigned char*)d_ws + WS_CTL, 0, CTL_BYTES, stream); }
    Args a{};
    for (int i = 0; i < 19; ++i) a.in[i] = (const float*)d_in[i];
    a.out = (float*)d_out; a.ws = (unsigned char*)d_ws;
#if MK_N_LAUNCHES == 1
    a.ph_lo = 0; a.ph_hi = 7;
    { void* kargs[] = {&a};
      if (MK_REPEAT == 9) { (void)hipLaunchCooperativeKernel((const void*)mk_fwd, dim3(grid), dim3(NTHREADS), kargs, LDS_BYTES, stream);
                            (void)hipMemsetAsync((unsigned char*)d_ws + WS_CTL, 0, CTL_BYTES, stream); }
      if (MK_REPEAT == 10) { Args e0 = a; e0.ph_lo = 0; e0.ph_hi = 0; void* k0[] = {&e0};
                            (void)hipLaunchCooperativeKernel((const void*)mk_fwd, dim3(grid), dim3(NTHREADS), k0, LDS_BYTES, stream);
                            (void)hipMemsetAsync((unsigned char*)d_ws + WS_CTL, 0, CTL_BYTES, stream); }
      hipError_t e = hipLaunchCooperativeKernel((const void*)mk_fwd, dim3(grid), dim3(NTHREADS), kargs, LDS_BYTES, stream);
      if (e != hipSuccess) fprintf(stderr, "cooperative launch failed: %s (grid %d)\n", hipGetErrorString(e), grid);
      if (MK_REPEAT >= 100) {
          Args e1 = a; e1.ph_lo = MK_REPEAT - 100; e1.ph_hi = MK_REPEAT - 99; void* k1[] = {&e1};
          (void)hipMemsetAsync((unsigned char*)d_ws + WS_CTL, 0, CTL_BYTES, stream);
          (void)hipLaunchCooperativeKernel((const void*)mk_fwd, dim3(grid), dim3(NTHREADS), k1, LDS_BYTES, stream);
          if (MK_REPEAT == 101) { Args e2 = a; e2.ph_lo = 6; e2.ph_hi = 7; void* k2[] = {&e2};
              (void)hipMemsetAsync((unsigned char*)d_ws + WS_CTL, 0, CTL_BYTES, stream);
              (void)hipLaunchCooperativeKernel((const void*)mk_fwd, dim3(grid), dim3(NTHREADS), k2, LDS_BYTES, stream); }
      } }
#else
    for (int ph = 0; ph < 7; ++ph) {
        a.ph_lo = ph; a.ph_hi = ph + 1;
        hipLaunchKernelGGL(mk_fwd, dim3(grid), dim3(NTHREADS), LDS_BYTES, stream, a);
    }
#endif
}
```

```cpp
#include <hip/hip_runtime.h>
#include <hip/hip_cooperative_groups.h>
#include <cstdio>
#include <cstdint>
namespace cg = cooperative_groups;

#ifndef MK_N_LAUNCHES
#define MK_N_LAUNCHES 1
#endif

#ifndef MK_REPEAT
#define MK_REPEAT -1
#endif
#define LAS __attribute__((address_space(3)))
typedef unsigned short bf16_t;
typedef short bf16x8 __attribute__((ext_vector_type(8)));
typedef float f32x4 __attribute__((ext_vector_type(4)));
typedef float f32x2 __attribute__((ext_vector_type(2)));
typedef unsigned u32x4 __attribute__((ext_vector_type(4)));
typedef unsigned u32x2 __attribute__((ext_vector_type(2)));
typedef short v4i16_t __attribute__((ext_vector_type(4)));

constexpr int D = 1024, NPROMPT = 8 * 2048, NSAMPLE = 128 * 4, M = NPROMPT + NSAMPLE;
constexpr int NIN = 9 * 1024, PD = 256, NPM = M / 256;
constexpr float EPS = 1e-6f, LN_EPS = 1e-5f;
constexpr size_t O_YP = 0, O_YS = (size_t)NPROMPT * D, O_CP = (size_t)M * D, O_CS = O_CP + 8 * 2 * 1024, O_VP = O_CS + 128 * 2 * 1024, O_VS = O_VP + 8 * 128 * 1024;
constexpr size_t U = (size_t)M * D * 2;
constexpr size_t WS_W1 = 0;
constexpr size_t WS_W2 = WS_W1 + (size_t)NIN * D * 2;
constexpr size_t WS_W3 = WS_W2 + (size_t)2048 * D * 2;
constexpr size_t WS_W4 = WS_W3 + (size_t)D * D * 2;
constexpr size_t WS_W5 = WS_W4 + (size_t)D * D * 2;
constexpr size_t WS_WS = WS_W5 + (size_t)D * PD * 2;
constexpr size_t WS_PB = WS_WS + (size_t)8 * 128 * 128 * 2;
constexpr size_t WS_VST = WS_PB + (size_t)M * PD * 2;
constexpr size_t WS_ST1 = WS_VST + (size_t)M * 16 * 8;
constexpr size_t WS_ST2 = WS_ST1 + (size_t)M * 16 * 4;
constexpr size_t WS_INV = WS_ST2 + (size_t)M * 16 * 4;
constexpr size_t WS_S0 = WS_INV + 131072;
constexpr size_t WS_CTL = WS_S0 + 6 * U;
constexpr size_t CTL_BYTES = 16384;
constexpr size_t WS_END = WS_CTL + CTL_BYTES;
static_assert(WS_END <= 268435456ull, "workspace map exceeds 256 MiB");
static_assert(WS_S0 % 256 == 0 && WS_PB % 256 == 0 && WS_VST % 256 == 0, "alignment");

__device__ __forceinline__ unsigned cvt_pk_bf16(float lo, float hi) { unsigned r; asm volatile("v_cvt_pk_bf16_f32 %0, %1, %2" : "=v"(r) : "v"(lo), "v"(hi)); return r; }
__device__ __forceinline__ unsigned f2bf(float f) { unsigned u = __builtin_bit_cast(unsigned, f); return (u + 0x7fffu + ((u >> 16) & 1u)) >> 16; }
__device__ __forceinline__ float bflo(unsigned w) { return __builtin_bit_cast(float, w << 16); }
__device__ __forceinline__ float bfhi(unsigned w) { return __builtin_bit_cast(float, w & 0xffff0000u); }
__device__ __forceinline__ float fsigmoid(float x) { return __builtin_amdgcn_rcpf(1.0f + __builtin_amdgcn_exp2f(-1.4426950409f * x)); }
__device__ __forceinline__ float fsilu(float x) { return x * fsigmoid(x); }
__device__ __forceinline__ float fgelu(float x) { const float u = x * (1.5957691216f + 0.0713548163f * x * x); return x * fsigmoid(u); }
__device__ __forceinline__ float wave_sum(float v) {
#pragma unroll
    for (int o = 1; o < 64; o <<= 1) v += __shfl_xor(v, o);
    return v;
}
__device__ __forceinline__ unsigned q8(float v) { return (unsigned)(v * 255.0f + 0.5f); }
__device__ __forceinline__ unsigned pack4_u8(float a, float b, float c, float d) { return q8(a) | (q8(b) << 8) | (q8(c) << 16) | (q8(d) << 24); }
#define UNPACK8_U8(V_, F_) do { F_[0] = (float)((V_)[0] & 255u); F_[1] = (float)(((V_)[0] >> 8) & 255u); F_[2] = (float)(((V_)[0] >> 16) & 255u); F_[3] = (float)((V_)[0] >> 24); \
                                F_[4] = (float)((V_)[1] & 255u); F_[5] = (float)(((V_)[1] >> 8) & 255u); F_[6] = (float)(((V_)[1] >> 16) & 255u); F_[7] = (float)((V_)[1] >> 24); } while (0)
#define UNPACK8(V_, F_) do { F_[0] = bflo((V_)[0]); F_[1] = bfhi((V_)[0]); F_[2] = bflo((V_)[1]); F_[3] = bfhi((V_)[1]); F_[4] = bflo((V_)[2]); F_[5] = bfhi((V_)[2]); F_[6] = bflo((V_)[3]); F_[7] = bfhi((V_)[3]); } while (0)

namespace pg8 {
constexpr int BM = 256, BK = 64, HALF = 128, HTB = HALF * BK * 2, STAGE_BYTES = 8 * HTB, NXCD = 8, WGM = 8;
__host__ __device__ __forceinline__ int lds_byte(int r, int c) { const int st = (r >> 4) * 2 + (c >> 5), rr = r & 15, cc = c & 31, ob = rr * 64 + cc * 2; return st * 1024 + (ob ^ (((ob >> 9) & 1) << 5)); }
__host__ __device__ __forceinline__ void stage_rc(int b, int& R, int& C) { const int st = b / 1024, sb = b % 1024, swz = sb ^ (((sb >> 9) & 1) << 5); R = (st >> 1) * 16 + swz / 64; C = (st & 1) * 32 + (swz % 64) / 2; }
__host__ __device__ __forceinline__ int perm32(int rho) { const int n = rho >> 4, i = rho & 15; return 8 * (i >> 2) + 4 * n + (i & 3); }

struct Unit { int pm, pn, rm, rn, half; };
struct Gemm { const bf16_t* A; const bf16_t* Bt; int M, N, K; };

struct StaticOrder {
    int nM, nN, nwg, G, c;
    __host__ __device__ void init(int M_, int N_, int G_, int c_) { nM = M_ / BM; nN = N_ / BM; nwg = nM * nN; G = G_; c = c_; }
    __host__ __device__ bool next(int i, Unit& u) const {
        const long L = (long)i * G + c; if (L >= nwg) return false;
        int wgid = (int)L; { const int q = nwg / NXCD, r = nwg % NXCD, xcd = wgid % NXCD, off = wgid / NXCD; wgid = (xcd < r ? xcd * (q + 1) : r * (q + 1) + (xcd - r) * q) + off; }
        const int nig = WGM * nN, gid = wgid / nig, fm = gid * WGM, gsz = (nM - fm) < WGM ? (nM - fm) : WGM;
        u.pm = fm + ((wgid % nig) % gsz); u.pn = (wgid % nig) / gsz; u.rm = u.pm; u.rn = u.pn; u.half = 0; return true;
    }
    __device__ __forceinline__ void a_ready(const Unit&) const {}
    __device__ __forceinline__ void done(const Unit&) const {}
};
struct PairOrder {
    StaticOrder so; int dM, dN;
    __host__ __device__ void init(int M_, int N_, int G_, int c_, int Mstack) { so.init(M_, N_, G_, c_); dM = Mstack / BM; dN = N_ / BM; }
    __host__ __device__ bool next(int i, Unit& u) const {
        Unit t; if (!so.next(i >> 1, t)) return false;
        const int h = i & 1; u.rm = t.pm; u.rn = t.pn; u.half = h; u.pm = t.pm + h * dM; u.pn = t.pn + h * dN; return true;
    }
    __device__ __forceinline__ void a_ready(const Unit&) const {}
    __device__ __forceinline__ void done(const Unit&) const {}
};

struct SlackOrder {
    int G, c, first, ns;
    __host__ __device__ void init(int G_, int c_, int first_) { G = G_; c = c_; first = (first_ > 0 && first_ < G_) ? first_ : 0; ns = G_ - first; }
    __host__ __device__ bool next(int i, Unit& u) const {
        if (c < first) return false;
        const int idx = (c - first) + i * ns; if (idx >= 256) return false;
        u.pm = u.rm = idx >> 2; u.pn = u.rn = idx & 3; u.half = 0; return true;
    }
    __device__ __forceinline__ void a_ready(const Unit&) const {}
    __device__ __forceinline__ void done(const Unit&) const {}
};

struct P1Order {
    StaticOrder so; int G, c;
    __host__ __device__ void init(int G_, int c_) { so.init(16384, 9216, G_, c_); G = G_; c = c_; }
    __host__ __device__ bool next(int i, Unit& u) const {
        const int L = i * G + c, nwg = 2304; int pm, pn;
        if (L < nwg) { const int q = nwg / NXCD, xcd = L % NXCD, off = L / NXCD, wgid = xcd * q + off;
                       const int nig = WGM * 36, fm = (wgid / nig) * WGM; pm = fm + ((wgid % nig) % WGM); pn = (wgid % nig) / WGM; }
        else { const int idx = L - nwg; if (idx >= 72) return false; pm = 64 + idx / 36; pn = idx % 36; }
        u.pm = pm; u.pn = pn; u.rm = pm; u.rn = pn; u.half = 0; return true;
    }
    __device__ __forceinline__ void a_ready(const Unit&) const {}
    __device__ __forceinline__ void done(const Unit&) const {}
};

template <class Epi, class Sched, bool ALIGN_EPI = false, bool SP2 = false>
__device__ __forceinline__ void gemm_phase(LAS unsigned char* lds, const Gemm g, const Sched& S, const Epi& E) {
    const int tid = threadIdx.x, wid = __builtin_amdgcn_readfirstlane(tid >> 6), lane = tid & 63, wr = wid >> 2, wc = wid & 3, fr = lane & 15, fq = lane >> 4;
    const int K = g.K, nt = K / BK;
    unsigned voffA[2], voffB[2];
#pragma unroll
    for (int i = 0; i < 2; ++i) { int R, C; stage_rc(tid * 16 + i * 8192, R, C); const int Rb = Epi::PERM ? ((R & ~31) + perm32(R & 31)) : R;
        voffA[i] = (unsigned)(R * K + C) * 2u; voffB[i] = (unsigned)(Rb * K + C) * 2u; }
    const size_t kstep = (size_t)(BK * 2);
    const size_t hstep = (size_t)HALF * K * 2;
    const size_t tstep = 2 * hstep;
    const unsigned ldsw = (unsigned)wid * 1024u;
    const int aoff = lds_byte(wr * 64 + fr, fq * 8), boff = lds_byte(wc * 32 + fr, fq * 8);
#define PG8_SA(b, h) (((b) * 2 + (h)) * HTB)
#define PG8_SB(b, h) ((4 + (b) * 2 + (h)) * HTB)
#define PG8_STAGE(bufoff, gbase, voff) do { _Pragma("unroll") for (int _i = 0; _i < 2; ++_i) \
        __builtin_amdgcn_global_load_lds((const unsigned*)((const char*)(gbase) + (voff)[_i]), (LAS unsigned*)(lds + (bufoff) + ldsw + _i * 8192), 16, 0, 0); } while (0)
#define PG8_LDA(dst, b, h) do { _Pragma("unroll") for (int m = 0; m < 4; ++m) _Pragma("unroll") for (int k = 0; k < 2; ++k) dst[m][k] = *(const LAS bf16x8*)(lds + PG8_SA(b, h) + aoff + m * 2048 + k * 1024); } while (0)
#define PG8_LDB(dst, b, h) do { _Pragma("unroll") for (int n = 0; n < 2; ++n) _Pragma("unroll") for (int k = 0; k < 2; ++k) dst[n][k] = *(const LAS bf16x8*)(lds + PG8_SB(b, h) + boff + n * 2048 + k * 1024); } while (0)
#define PG8_MMA(ai, bj, At, Bt) do { __builtin_amdgcn_s_setprio(1); _Pragma("unroll") for (int m = 0; m < 4; ++m) _Pragma("unroll") for (int n = 0; n < 2; ++n) _Pragma("unroll") for (int k = 0; k < 2; ++k) \
        acc[ai][bj][m][n] = __builtin_amdgcn_mfma_f32_16x16x32_bf16(Bt[n][k], At[m][k], acc[ai][bj][m][n], 0, 0, 0); __builtin_amdgcn_s_setprio(0); } while (0)
#define PG8_WAIT_V(n) asm volatile("s_waitcnt vmcnt(" #n ")" ::: "memory")
#define PG8_WAIT_L(n) asm volatile("s_waitcnt lgkmcnt(" #n ")" ::: "memory")
#define PG8_BAR __builtin_amdgcn_s_barrier()
#define PG8_SCHED __builtin_amdgcn_sched_barrier(0)
    Unit cur, nxt; int ui = 0;
    if (!S.next(0, cur)) return;
    f32x4 acc[2][2][4][2];
    E.init(acc, cur, wr, wc, fr, fq);
    bf16x8 At[4][2], B0[2][2], B1[2][2];
    const char* cA = (const char*)g.A + (size_t)cur.pm * tstep; const char* cB = (const char*)g.Bt + (size_t)cur.pn * tstep;
    S.a_ready(cur);
    if constexpr (SP2) {
        PG8_STAGE(PG8_SB(0, 0), cB, voffB); PG8_STAGE(PG8_SB(0, 1), cB + hstep, voffB); PG8_STAGE(PG8_SA(0, 0), cA, voffA); PG8_STAGE(PG8_SA(0, 1), cA + hstep, voffA);
        if (wr == 1) PG8_BAR;
        PG8_WAIT_V(2); PG8_BAR;
        PG8_STAGE(PG8_SB(1, 0), cB + kstep, voffB); PG8_STAGE(PG8_SA(1, 0), cA + kstep, voffA); PG8_STAGE(PG8_SB(1, 1), cB + hstep + kstep, voffB);
        PG8_WAIT_V(6); PG8_BAR;
    } else {
        PG8_STAGE(PG8_SB(0, 0), cB, voffB); PG8_STAGE(PG8_SA(0, 0), cA, voffA); PG8_STAGE(PG8_SB(0, 1), cB + hstep, voffB); PG8_STAGE(PG8_SA(0, 1), cA + hstep, voffA);
        if (wr == 1) PG8_BAR;
        PG8_WAIT_V(4); PG8_BAR;
        PG8_STAGE(PG8_SB(1, 0), cB + kstep, voffB); PG8_STAGE(PG8_SA(1, 0), cA + kstep, voffA); PG8_STAGE(PG8_SB(1, 1), cB + hstep + kstep, voffB);
        PG8_WAIT_V(6); PG8_BAR;
    }
    for (;;) {
        const bool has_next = S.next(ui + 1, nxt);
        const char* nA = has_next ? (const char*)g.A + (size_t)nxt.pm * tstep : cA; const char* nB = has_next ? (const char*)g.Bt + (size_t)nxt.pn * tstep : cB;
#pragma nounroll
        for (int t = 0; t < nt; t += 2) {
            const bool last = (t == nt - 2);
            const char* a1 = cA + (size_t)(t + 1) * kstep;
            const char* a2 = last ? nA : cA + (size_t)(t + 2) * kstep; const char* b2 = last ? nB : cB + (size_t)(t + 2) * kstep;
            const char* a3 = a2 + kstep; const char* b3 = b2 + kstep;
            if (last && has_next) S.a_ready(nxt);
            if constexpr (SP2) {
            PG8_LDB(B0, 0, 0); PG8_LDB(B1, 0, 1); PG8_SCHED; PG8_LDA(At, 0, 0); PG8_STAGE(PG8_SA(1, 1), a1 + hstep, voffA);
            PG8_WAIT_V(8); PG8_WAIT_L(0); PG8_BAR; PG8_MMA(0, 0, At, B0); PG8_MMA(0, 1, At, B1); PG8_BAR; PG8_SCHED;
            PG8_LDA(At, 0, 1); PG8_STAGE(PG8_SB(0, 0), b2, voffB); PG8_STAGE(PG8_SB(0, 1), b2 + hstep, voffB); PG8_STAGE(PG8_SA(0, 0), a2, voffA);
            PG8_WAIT_V(8); PG8_WAIT_L(0); PG8_BAR; PG8_MMA(1, 0, At, B0); PG8_MMA(1, 1, At, B1); PG8_BAR; PG8_SCHED;
            PG8_LDB(B0, 1, 0); PG8_LDB(B1, 1, 1); PG8_SCHED; PG8_LDA(At, 1, 0); PG8_STAGE(PG8_SA(0, 1), a2 + hstep, voffA);
            PG8_WAIT_V(8); PG8_WAIT_L(0); PG8_BAR; PG8_MMA(0, 0, At, B0); PG8_MMA(0, 1, At, B1); PG8_BAR; PG8_SCHED;
            PG8_LDA(At, 1, 1); PG8_STAGE(PG8_SB(1, 0), b3, voffB); PG8_STAGE(PG8_SB(1, 1), b3 + hstep, voffB); PG8_STAGE(PG8_SA(1, 0), a3, voffA);
            PG8_WAIT_V(8); PG8_WAIT_L(0); PG8_BAR; PG8_MMA(1, 0, At, B0); PG8_MMA(1, 1, At, B1); PG8_BAR; PG8_SCHED;
            } else {
            PG8_LDB(B0, 0, 0); PG8_SCHED; PG8_LDA(At, 0, 0); PG8_STAGE(PG8_SA(1, 1), a1 + hstep, voffA);
            PG8_WAIT_L(8); PG8_BAR; PG8_WAIT_L(0); PG8_MMA(0, 0, At, B0); PG8_BAR; PG8_SCHED;
            PG8_LDB(B1, 0, 1); PG8_STAGE(PG8_SB(0, 0), b2, voffB);
            PG8_BAR; PG8_WAIT_L(0); PG8_MMA(0, 1, At, B1); PG8_BAR;
            PG8_LDA(At, 0, 1); PG8_STAGE(PG8_SA(0, 0), a2, voffA);
            PG8_BAR; PG8_WAIT_L(0); PG8_MMA(1, 0, At, B0); PG8_BAR; PG8_SCHED;
            PG8_STAGE(PG8_SB(0, 1), b2 + hstep, voffB);
            PG8_WAIT_V(6); PG8_BAR; PG8_MMA(1, 1, At, B1); PG8_BAR;
            PG8_LDB(B0, 1, 0); PG8_SCHED; PG8_LDA(At, 1, 0); PG8_STAGE(PG8_SA(0, 1), a2 + hstep, voffA);
            PG8_WAIT_L(8); PG8_BAR; PG8_WAIT_L(0); PG8_MMA(0, 0, At, B0); PG8_BAR; PG8_SCHED;
            PG8_LDB(B1, 1, 1); PG8_STAGE(PG8_SB(1, 0), b3, voffB);
            PG8_BAR; PG8_WAIT_L(0); PG8_MMA(0, 1, At, B1); PG8_BAR;
            PG8_LDA(At, 1, 1); PG8_STAGE(PG8_SA(1, 0), a3, voffA);
            PG8_BAR; PG8_WAIT_L(0); PG8_MMA(1, 0, At, B0); PG8_BAR; PG8_SCHED;
            PG8_STAGE(PG8_SB(1, 1), b3 + hstep, voffB);
            PG8_WAIT_V(6); PG8_BAR; PG8_MMA(1, 1, At, B1); PG8_BAR;
            }
        }
        if constexpr (ALIGN_EPI) { if (wr == 0) PG8_BAR; }
        const bool keep = E(acc, cur, wr, wc, fr, fq);
        S.done(cur);
        if (!has_next) break;
        if (!keep) E.init(acc, nxt, wr, wc, fr, fq);
        cur = nxt; cA = nA; cB = nB; ++ui;
        if constexpr (ALIGN_EPI) { if (wr == 1) PG8_BAR; }
    }
    PG8_WAIT_V(0);
    if constexpr (!ALIGN_EPI) { if (wr == 0) PG8_BAR; }
    PG8_BAR;
#undef PG8_SA
#undef PG8_SB
#undef PG8_STAGE
#undef PG8_LDA
#undef PG8_LDB
#undef PG8_MMA
#undef PG8_WAIT_V
#undef PG8_WAIT_L
#undef PG8_BAR
#undef PG8_SCHED
}
}
using pg8::Unit;

__device__ __forceinline__ void acc_zero(f32x4 (&acc)[2][2][4][2]) {
#pragma unroll
    for (int a = 0; a < 2; ++a)
#pragma unroll
        for (int b = 0; b < 2; ++b)
#pragma unroll
            for (int m = 0; m < 4; ++m)
#pragma unroll
                for (int n = 0; n < 2; ++n) acc[a][b][m][n] = (f32x4){0.f, 0.f, 0.f, 0.f};
}
#define EPI_ZERO_INIT __device__ __forceinline__ void init(f32x4 (&acc)[2][2][4][2], const Unit&, int, int, int, int) const { acc_zero(acc); }
#define PACK8(o) ((u32x4){cvt_pk_bf16(o[0], o[1]), cvt_pk_bf16(o[2], o[3]), cvt_pk_bf16(o[4], o[5]), cvt_pk_bf16(o[6], o[7])})

constexpr size_t SM_CHS = 0, SM_BGS = SM_CHS + (size_t)NSAMPLE * 1024, SM_CHF = SM_BGS + (size_t)NSAMPLE * 1024, SM_BGF = SM_CHF + 256 * 2 * 1024, SM_CHL = SM_BGF + 256 * 2 * 1024;
struct Epi1 {
    static constexpr bool PERM = true;
    EPI_ZERO_INIT
    bf16_t *UG, *VG, *SMB; unsigned char* SAq; f32x2* vst; float* out; const float* convw;
    __device__ __forceinline__ bool operator()(f32x4 (&acc)[2][2][4][2], const Unit& u, int wr, int wc, int fr, int fq) const {
        const int pn = u.pn; const int row0 = u.pm * 256 + wr * 64 + fr;
        if (pn < 8) {
            const int col = pn * 128 + wc * 32 + 8 * fq;
#pragma unroll
            for (int ai = 0; ai < 2; ++ai)
#pragma unroll
                for (int m = 0; m < 4; ++m) {
                    const int row = row0 + ai * 128 + m * 16;
                    float o[8];
#pragma unroll
                    for (int i = 0; i < 4; ++i) { o[i] = fgelu(acc[ai][0][m][0][i]) * fsilu(acc[ai][1][m][0][i]); o[4 + i] = fgelu(acc[ai][0][m][1][i]) * fsilu(acc[ai][1][m][1][i]); }
                    *(u32x4*)(UG + (size_t)row * 1024 + col) = PACK8(o);
                }
        } else if (pn < 24) {
            const int col = (pn - 8) * 64 + wc * 16 + 4 * fq; const int lane = fq * 16 + fr;
            const f32x4 w0 = *(const f32x4*)(convw + col), w1 = *(const f32x4*)(convw + 1024 + col), w2 = *(const f32x4*)(convw + 2048 + col);
            bf16_t* YBp = UG + (size_t)M * D;
            const int src1 = (lane & 48) | ((fr + 15) & 15), src2 = (lane & 48) | ((fr + 14) & 15);
#pragma unroll
            for (int ai = 0; ai < 2; ++ai) {
                f32x4 chp = (f32x4){0.f, 0.f, 0.f, 0.f};
#pragma unroll
                for (int m = 0; m < 4; ++m) {
                    const int row = row0 + ai * 128 + m * 16;
                    const f32x4 ch = acc[ai][0][m][0] * acc[ai][0][m][1];
                    f32x4 bg;
#pragma unroll
                    for (int i = 0; i < 4; ++i) bg[i] = acc[ai][1][m][0][i] * fsilu(acc[ai][1][m][1][i]);
                    bool cs; size_t oidx;
                    if (row < NPROMPT) { const int t = row & 2047; cs = t >= 2046; oidx = O_CP + (size_t)((row >> 11) * 2 + (t - 2046)) * 1024 + col; }
                    else { const int r = row - NPROMPT, t = r & 3; cs = t >= 2; oidx = O_CS + (size_t)((r >> 2) * 2 + (t - 2)) * 1024 + col; }
                    if (cs) *(f32x4*)(out + oidx) = ch;
                    const u32x2 chw = (u32x2){cvt_pk_bf16(ch[0], ch[1]), cvt_pk_bf16(ch[2], ch[3])};
                    if (u.pm >= NPROMPT / 256) {
                        const size_t so = (size_t)(row - NPROMPT) * 1024 + col;
                        *(u32x2*)(SMB + SM_CHS + so) = chw; *(u32x2*)(SMB + SM_BGS + so) = (u32x2){cvt_pk_bf16(bg[0], bg[1]), cvt_pk_bf16(bg[2], bg[3])};
                    } else {
                        f32x4 p1, p2;
#pragma unroll
                        for (int i = 0; i < 4; ++i) {
                            const float a1 = __shfl(ch[i], src1), b1 = __shfl(chp[i], src1), a2 = __shfl(ch[i], src2), b2 = __shfl(chp[i], src2);
                            p1[i] = fr == 0 ? b1 : a1; p2[i] = fr < 2 ? b2 : a2;
                        }
                        const int blk = row >> 6;
                        if (m == 0 && fr < 2) {
                            *(u32x2*)(SMB + SM_CHF + (size_t)(blk * 2 + fr) * 1024 + col) = chw;
                            *(u32x2*)(SMB + SM_BGF + (size_t)(blk * 2 + fr) * 1024 + col) = (u32x2){cvt_pk_bf16(bg[0], bg[1]), cvt_pk_bf16(bg[2], bg[3])};
                        } else {
                            const f32x4 y = bg * (w0 * p2 + w1 * p1 + w2 * ch);
                            *(u32x2*)(YBp + (size_t)row * 1024 + col) = (u32x2){cvt_pk_bf16(y[0], y[1]), cvt_pk_bf16(y[2], y[3])};
                        }
                        if (m == 3 && fr >= 14) *(u32x2*)(SMB + SM_CHL + (size_t)(blk * 2 + (fr - 14)) * 1024 + col) = chw;
                    }
                    chp = ch;
                }
            }
        } else {
            const int kind = (pn - 24) >> 2, q = (pn - 24) & 3; bf16_t* O = VG; unsigned char* Oq = SAq + (size_t)(kind == 2 ? 1 : 0) * ((size_t)M * D);
            const int col = q * 256 + wc * 32 + 8 * fq;
#pragma unroll
            for (int ai = 0; ai < 2; ++ai)
#pragma unroll
                for (int m = 0; m < 4; ++m) {
                    const int row = row0 + ai * 128 + m * 16;
                    float s = 0.f, ss = 0.f;
#pragma unroll
                    for (int bj = 0; bj < 2; ++bj) {
                        float a[8], o[8];
#pragma unroll
                        for (int i = 0; i < 4; ++i) { a[i] = acc[ai][bj][m][0][i]; a[4 + i] = acc[ai][bj][m][1][i]; }
                        if (kind == 0) {
#pragma unroll
                            for (int i = 0; i < 8; ++i) { o[i] = fgelu(a[i]); s += o[i]; ss += o[i] * o[i]; }
                            *(u32x4*)(O + (size_t)row * 1024 + col + bj * 128) = PACK8(o);
                        } else {
#pragma unroll
                            for (int i = 0; i < 8; ++i) o[i] = fsigmoid(a[i]);
                            *(u32x2*)(Oq + (size_t)row * 1024 + col + bj * 128) = (u32x2){pack4_u8(o[0], o[1], o[2], o[3]), pack4_u8(o[4], o[5], o[6], o[7])};
                        }
                    }
                    if (kind == 0) {
                        s += __shfl_xor(s, 16); s += __shfl_xor(s, 32); ss += __shfl_xor(ss, 16); ss += __shfl_xor(ss, 32);
                        if (fq == 0) vst[(size_t)row * 16 + q * 4 + wc] = (f32x2){s, ss};
                    }
                }
        }
        return false;
    }
};

struct Epi2 {
    static constexpr bool PERM = true;
    EPI_ZERO_INIT
    const unsigned char *SAq, *SBq; bf16_t* MG;
    __device__ __forceinline__ bool operator()(f32x4 (&acc)[2][2][4][2], const Unit& u, int wr, int wc, int fr, int fq) const {
        const int row0 = u.rm * 256 + wr * 64 + fr, col0 = u.rn * 256 + wc * 32 + 8 * fq;
        u32x2 wb[2][4][2], wa[2][4][2];
#pragma unroll
        for (int ai = 0; ai < 2; ++ai)
#pragma unroll
            for (int m = 0; m < 4; ++m)
#pragma unroll
                for (int bj = 0; bj < 2; ++bj) {
                    const size_t off = (size_t)(row0 + ai * 128 + m * 16) * 1024 + col0 + bj * 128;
                    wb[ai][m][bj] = *(const u32x2*)(SBq + off); if (u.half == 0) wa[ai][m][bj] = *(const u32x2*)(SAq + off);
                }
#pragma unroll
        for (int ai = 0; ai < 2; ++ai)
#pragma unroll
            for (int m = 0; m < 4; ++m)
#pragma unroll
                for (int bj = 0; bj < 2; ++bj) {
                    const size_t off = (size_t)(row0 + ai * 128 + m * 16) * 1024 + col0 + bj * 128;
                    float sb[8]; UNPACK8_U8(wb[ai][m][bj], sb);
                    if (u.half == 0) {
                        float sa[8]; UNPACK8_U8(wa[ai][m][bj], sa);
#pragma unroll
                        for (int i = 0; i < 4; ++i) { acc[ai][bj][m][0][i] *= sa[i] * __builtin_amdgcn_rcpf(fmaxf(sb[i], 0.5f)); acc[ai][bj][m][1][i] *= sa[4 + i] * __builtin_amdgcn_rcpf(fmaxf(sb[4 + i], 0.5f)); }
                    } else {
                        float o[8];
#pragma unroll
                        for (int i = 0; i < 4; ++i) { o[i] = acc[ai][bj][m][0][i] * (fmaxf(sb[i], 0.5f) * (1.0f / 255.0f)); o[4 + i] = acc[ai][bj][m][1][i] * (fmaxf(sb[4 + i], 0.5f) * (1.0f / 255.0f)); }
                        *(u32x4*)(MG + off) = PACK8(o);
                    }
                }
        return u.half == 0;
    }
};

struct EpiP {
    static constexpr bool PERM = true;
    EPI_ZERO_INIT
    bf16_t* O;
    __device__ __forceinline__ bool operator()(f32x4 (&acc)[2][2][4][2], const Unit& u, int wr, int wc, int fr, int fq) const {
        const int row0 = u.rm * 256 + wr * 64 + fr, col0 = u.rn * 256 + wc * 32 + 8 * fq;
#pragma unroll
        for (int ai = 0; ai < 2; ++ai)
#pragma unroll
            for (int m = 0; m < 4; ++m)
#pragma unroll
                for (int bj = 0; bj < 2; ++bj) {
                    float o[8];
#pragma unroll
                    for (int i = 0; i < 4; ++i) { o[i] = acc[ai][bj][m][0][i]; o[4 + i] = acc[ai][bj][m][1][i]; }
                    *(u32x4*)(O + (size_t)(row0 + ai * 128 + m * 16) * 1024 + col0 + bj * 128) = PACK8(o);
                }
        return false;
    }
};

struct EpiRaw {
    static constexpr bool PERM = true;
    EPI_ZERO_INIT
    bf16_t* O;
    __device__ __forceinline__ bool operator()(f32x4 (&acc)[2][2][4][2], const Unit& u, int wr, int wc, int fr, int fq) const {
        const int row0 = u.rm * 256 + wr * 64 + fr, col0 = (u.rn & 3) * 256 + wc * 32 + 8 * fq;
#pragma unroll
        for (int ai = 0; ai < 2; ++ai)
#pragma unroll
            for (int m = 0; m < 4; ++m)
#pragma unroll
                for (int bj = 0; bj < 2; ++bj) {
                    float o[8];
#pragma unroll
                    for (int i = 0; i < 4; ++i) { o[i] = acc[ai][bj][m][0][i]; o[4 + i] = acc[ai][bj][m][1][i]; }
                    *(u32x4*)(O + (size_t)(row0 + ai * 128 + m * 16) * 1024 + col0 + bj * 128) = PACK8(o);
                }
        return false;
    }
};

struct Epi3 {
    static constexpr bool PERM = true;
    const bf16_t* XBn; const float* inv; bf16_t* X1b; float* st1;
    __device__ __forceinline__ void init(f32x4 (&acc)[2][2][4][2], const Unit& u, int wr, int wc, int fr, int fq) const {
        const int row0 = u.rm * 256 + wr * 64 + fr, col0 = u.rn * 256 + wc * 32 + 8 * fq;
        u32x4 xw[2][4][2]; float iv[2][4];
#pragma unroll
        for (int ai = 0; ai < 2; ++ai)
#pragma unroll
            for (int m = 0; m < 4; ++m) {
                iv[ai][m] = inv[row0 + ai * 128 + m * 16];
#pragma unroll
                for (int bj = 0; bj < 2; ++bj) xw[ai][m][bj] = __builtin_nontemporal_load((const u32x4*)(XBn + (size_t)(row0 + ai * 128 + m * 16) * 1024 + col0 + bj * 128));
            }
#pragma unroll
        for (int ai = 0; ai < 2; ++ai)
#pragma unroll
            for (int m = 0; m < 4; ++m)
#pragma unroll
                for (int bj = 0; bj < 2; ++bj) {
                    float xv[8]; UNPACK8(xw[ai][m][bj], xv);
                    acc[ai][bj][m][0] = (f32x4){xv[0], xv[1], xv[2], xv[3]} * iv[ai][m]; acc[ai][bj][m][1] = (f32x4){xv[4], xv[5], xv[6], xv[7]} * iv[ai][m];
                }
    }
    __device__ __forceinline__ bool operator()(f32x4 (&acc)[2][2][4][2], const Unit& u, int wr, int wc, int fr, int fq) const {
        const int row0 = u.rm * 256 + wr * 64 + fr, col0 = u.rn * 256 + wc * 32 + 8 * fq;
#pragma unroll
        for (int ai = 0; ai < 2; ++ai)
#pragma unroll
            for (int m = 0; m < 4; ++m) {
                const int row = row0 + ai * 128 + m * 16;
                float ss = 0.f;
#pragma unroll
                for (int bj = 0; bj < 2; ++bj) {
                    const f32x4 v0 = acc[ai][bj][m][0], v1 = acc[ai][bj][m][1];
                    *(u32x4*)(X1b + (size_t)row * 1024 + col0 + bj * 128) = (u32x4){cvt_pk_bf16(v0[0], v0[1]), cvt_pk_bf16(v0[2], v0[3]), cvt_pk_bf16(v1[0], v1[1]), cvt_pk_bf16(v1[2], v1[3])};
                    ss += (v0[0] * v0[0] + v0[1] * v0[1]) + (v0[2] * v0[2] + v0[3] * v0[3]) + (v1[0] * v1[0] + v1[1] * v1[1]) + (v1[2] * v1[2] + v1[3] * v1[3]);
                }
                ss += __shfl_xor(ss, 16); ss += __shfl_xor(ss, 32);
                if (fq == 0) st1[(size_t)row * 16 + u.rn * 4 + wc] = ss;
            }
        return false;
    }
};

struct Epi4 {
    static constexpr bool PERM = true;
    EPI_ZERO_INIT
    const bf16_t* X1b; const bf16_t* PB; const float* st1; bf16_t* X2b; float* st2;
    __device__ __forceinline__ bool operator()(f32x4 (&acc)[2][2][4][2], const Unit& u, int wr, int wc, int fr, int fq) const {
        const int row0 = u.rm * 256 + wr * 64 + fr, col0 = u.rn * 256 + wc * 32 + 8 * fq;
#pragma unroll
        for (int ai = 0; ai < 2; ++ai)
#pragma unroll
            for (int mp = 0; mp < 2; ++mp) {
                u32x4 xw[2][2], pw[2][2]; f32x4 p4[2];
#pragma unroll
                for (int mm = 0; mm < 2; ++mm) {
                    const int row = row0 + ai * 128 + (2 * mp + mm) * 16;
                    p4[mm] = *(const f32x4*)(st1 + (size_t)row * 16 + 4 * fq);
#pragma unroll
                    for (int bj = 0; bj < 2; ++bj) { const size_t off = (size_t)row * 1024 + col0 + bj * 128; xw[mm][bj] = *(const u32x4*)(X1b + off); pw[mm][bj] = __builtin_nontemporal_load((const u32x4*)(PB + off)); }
                }
#pragma unroll
                for (int mm = 0; mm < 2; ++mm) {
                    const int m = 2 * mp + mm, row = row0 + ai * 128 + m * 16;
                    float s1 = (p4[mm][0] + p4[mm][1]) + (p4[mm][2] + p4[mm][3]); s1 += __shfl_xor(s1, 16); s1 += __shfl_xor(s1, 32);
                    const float rstd = __builtin_amdgcn_rsqf(s1 * (1.0f / 1024.0f) + EPS);
                    float ss = 0.f;
#pragma unroll
                    for (int bj = 0; bj < 2; ++bj) {
                        const size_t off = (size_t)row * 1024 + col0 + bj * 128;
                        float xv[8], pv[8]; UNPACK8(xw[mm][bj], xv); UNPACK8(pw[mm][bj], pv);
                        f32x4 v0, v1;
#pragma unroll
                        for (int i = 0; i < 4; ++i) { v0[i] = xv[i] + fsigmoid(rstd * acc[ai][bj][m][0][i]) * pv[i]; v1[i] = xv[4 + i] + fsigmoid(rstd * acc[ai][bj][m][1][i]) * pv[4 + i]; }
                        *(u32x4*)(X2b + off) = (u32x4){cvt_pk_bf16(v0[0], v0[1]), cvt_pk_bf16(v0[2], v0[3]), cvt_pk_bf16(v1[0], v1[1]), cvt_pk_bf16(v1[2], v1[3])};
                        ss += (v0[0] * v0[0] + v0[1] * v0[1]) + (v0[2] * v0[2] + v0[3] * v0[3]) + (v1[0] * v1[0] + v1[1] * v1[1]) + (v1[2] * v1[2] + v1[3] * v1[3]);
                    }
                    ss += __shfl_xor(ss, 16); ss += __shfl_xor(ss, 32);
                    if (fq == 0) st2[(size_t)row * 16 + u.rn * 4 + wc] = ss;
                }
                asm volatile("" ::: "memory");
            }
        return false;
    }
};

template <int K>
__device__ __forceinline__ f32x4 thin_gemm(LAS unsigned char* lds, const bf16_t* A, const bf16_t* Bt, int wave, int lane, int tid) {
    const int fr = lane & 15, g4 = lane >> 4, kw = wave * (K / 8);
    f32x4 acc[2][4];
#pragma unroll
    for (int i = 0; i < 2; ++i)
#pragma unroll
        for (int j = 0; j < 4; ++j) acc[i][j] = (f32x4){0.f, 0.f, 0.f, 0.f};
#pragma unroll
    for (int ks = 0; ks < K / 256; ++ks) {
        const int k = kw + 32 * ks + 8 * g4;
        bf16x8 af[2], bf[4];
#pragma unroll
        for (int i = 0; i < 2; ++i) af[i] = *(const bf16x8*)(A + (size_t)(16 * i + fr) * K + k);
#pragma unroll
        for (int j = 0; j < 4; ++j) bf[j] = *(const bf16x8*)(Bt + (size_t)(16 * j + fr) * K + k);
#pragma unroll
        for (int i = 0; i < 2; ++i)
#pragma unroll
            for (int j = 0; j < 4; ++j) acc[i][j] = __builtin_amdgcn_mfma_f32_16x16x32_bf16(bf[j], af[i], acc[i][j], 0, 0, 0);
    }
    LAS float* red = (LAS float*)lds;
#pragma unroll
    for (int i = 0; i < 2; ++i)
#pragma unroll
        for (int j = 0; j < 4; ++j) *(LAS f32x4*)(red + wave * 2176 + (16 * i + fr) * 68 + 16 * j + 4 * g4) = acc[i][j];
    __syncthreads();
    f32x4 sum = (f32x4){0.f, 0.f, 0.f, 0.f};
#pragma unroll
    for (int w = 0; w < 8; ++w) sum += *(const LAS f32x4*)(red + w * 2176 + (tid >> 4) * 68 + 4 * (tid & 15));
    __syncthreads();
    return sum;
}

__device__ __forceinline__ f32x4 thin_gemm_s(LAS unsigned char* lds, const bf16_t* A, const bf16_t* Bt, int wave, int lane, int tid) {
    constexpr int K = 1024, KH = 512, PITCH = 1040;
    const int fr = lane & 15, g4 = lane >> 4;
    f32x4 acc[2][4];
#pragma unroll
    for (int i = 0; i < 2; ++i)
#pragma unroll
        for (int j = 0; j < 4; ++j) acc[i][j] = (f32x4){0.f, 0.f, 0.f, 0.f};
    u32x4 st[12];
#pragma unroll
    for (int i = 0; i < 12; ++i) { const int r = wave * 12 + i; const bf16_t* rp = r < 32 ? A + (size_t)r * K : Bt + (size_t)(r - 32) * K; st[i] = *(const u32x4*)(rp + lane * 8); }
#pragma unroll
    for (int h = 0; h < 2; ++h) {
#pragma unroll
        for (int i = 0; i < 12; ++i) *(LAS u32x4*)(lds + (wave * 12 + i) * PITCH + lane * 16) = st[i];
        __syncthreads();
        if (h == 0) {
#pragma unroll
            for (int i = 0; i < 12; ++i) { const int r = wave * 12 + i; const bf16_t* rp = r < 32 ? A + (size_t)r * K : Bt + (size_t)(r - 32) * K; st[i] = *(const u32x4*)(rp + KH + lane * 8); }
        }
#pragma unroll
        for (int sx = 0; sx < 2; ++sx) {
            const int kb = ((2 * wave + sx) * 32 + 8 * g4) * 2;
            bf16x8 af[2], bf[4];
#pragma unroll
            for (int i = 0; i < 2; ++i) af[i] = *(const LAS bf16x8*)(lds + (16 * i + fr) * PITCH + kb);
#pragma unroll
            for (int j = 0; j < 4; ++j) bf[j] = *(const LAS bf16x8*)(lds + (32 + 16 * j + fr) * PITCH + kb);
#pragma unroll
            for (int i = 0; i < 2; ++i)
#pragma unroll
                for (int j = 0; j < 4; ++j) acc[i][j] = __builtin_amdgcn_mfma_f32_16x16x32_bf16(bf[j], af[i], acc[i][j], 0, 0, 0);
        }
        __syncthreads();
    }
    LAS float* red = (LAS float*)lds;
#pragma unroll
    for (int i = 0; i < 2; ++i)
#pragma unroll
        for (int j = 0; j < 4; ++j) *(LAS f32x4*)(red + wave * 2176 + (16 * i + fr) * 68 + 16 * j + 4 * g4) = acc[i][j];
    __syncthreads();
    f32x4 sum = (f32x4){0.f, 0.f, 0.f, 0.f};
#pragma unroll
    for (int w = 0; w < 8; ++w) sum += *(const LAS f32x4*)(red + w * 2176 + (tid >> 4) * 68 + 4 * (tid & 15));
    __syncthreads();
    return sum;
}

#define XB_TMO      128
#define XB_XCNT(j)  (256  + 64 * (j))
#define XB_XSUB(j)  (1280 + 64 * (j))
#define XB_XGEN(j)  (2304 + 64 * (j))
#define XB_TOP      3328
#define XB_TOPGEN   3392
#define XCD_BAR_WORDS 3456
#define XB_SPIN_CAP (1u << 18)
__device__ __forceinline__ unsigned xb_ld(unsigned* p)              { return __hip_atomic_load(p, __ATOMIC_RELAXED, __HIP_MEMORY_SCOPE_AGENT); }
__device__ __forceinline__ unsigned xb_add(unsigned* p, unsigned v) { return __hip_atomic_fetch_add(p, v, __ATOMIC_RELAXED, __HIP_MEMORY_SCOPE_AGENT); }
__device__ __forceinline__ unsigned xb_xcc_id() { return (unsigned)__builtin_amdgcn_s_getreg((3 << 11) | 20) & 0xFu; }
#define XB_SPIN(cond, bar) do { unsigned _sp = 0; while (cond) { __builtin_amdgcn_s_sleep(1); \
    if ((++_sp & 255u) == 0u) { if (xb_ld(&(bar)[XB_TMO])) break; if (_sp > XB_SPIN_CAP) { atomicAdd(&(bar)[XB_TMO], 1u); break; } } } } while (0)
struct XcdBarrier { unsigned* bar; unsigned x; volatile LAS unsigned* st; };
__device__ __forceinline__ XcdBarrier xcd_barrier_post(unsigned* bar, volatile LAS unsigned* st) {
    XcdBarrier b; b.bar = bar; b.x = xb_xcc_id(); b.st = st;
    if (threadIdx.x == 0) (void)xb_add(&bar[XB_XCNT(b.x)], 1u);
    return b;
}
__device__ __forceinline__ void xcd_barrier_complete(unsigned* bar, unsigned x, unsigned& nloc, unsigned& nx) {
    const unsigned G = gridDim.x * gridDim.y * gridDim.z;
    unsigned sum, cnt, mine, sp = 0u;
    for (;;) {
        sum = 0u; cnt = 0u; mine = 0u;
#pragma unroll
        for (unsigned j = 0; j < 16; ++j) { const unsigned c = xb_ld(&bar[XB_XCNT(j)]); sum += c; cnt += (c > 0u) ? 1u : 0u; mine = (j == x) ? c : mine; }
        if (sum == G) break;
        __builtin_amdgcn_s_sleep(1);
        if ((++sp & 255u) == 0u) { if (xb_ld(&bar[XB_TMO])) break; if (sp > XB_SPIN_CAP) { atomicAdd(&bar[XB_TMO], 1u); break; } }
    }
    nloc = mine > 0u ? mine : 1u; nx = cnt > 0u ? cnt : 1u;
}
__device__ __forceinline__ void xcd_barrier(const XcdBarrier& b) {
    asm volatile("s_waitcnt vmcnt(0)" ::: "memory");
    __syncthreads();
    if (threadIdx.x == 0) {
        unsigned* bar = b.bar;
        __builtin_amdgcn_s_waitcnt(0);
        unsigned nloc = b.st[0], nx = b.st[1];
        if (nloc == 0u) { xcd_barrier_complete(bar, b.x, nloc, nx); b.st[0] = nloc; b.st[1] = nx; }
        const unsigned old = xb_add(&bar[XB_XSUB(b.x)], 1u);
        const unsigned gen = old / nloc;
        if (old + 1u == (gen + 1u) * nloc) {
            __builtin_amdgcn_fence(__ATOMIC_RELEASE, "agent");
            asm volatile("s_waitcnt vmcnt(0)" ::: "memory");
            const unsigned og = xb_add(&bar[XB_TOP], 1u);
            const unsigned tg = og / nx;
            if (og + 1u == (tg + 1u) * nx) xb_add(&bar[XB_TOPGEN], 1u);
            else XB_SPIN(xb_ld(&bar[XB_TOPGEN]) == tg, bar);
            __builtin_amdgcn_fence(__ATOMIC_ACQUIRE, "agent");
            xb_add(&bar[XB_XGEN(b.x)], 1u);
            asm volatile("s_waitcnt vmcnt(0)" ::: "memory");
        } else {
            XB_SPIN(xb_ld(&bar[XB_XGEN(b.x)]) == gen, bar);
            __builtin_amdgcn_fence(__ATOMIC_ACQUIRE, "agent");
            asm volatile("s_waitcnt vmcnt(0)" ::: "memory");
        }
    }
    __syncthreads();
}

constexpr int NWAVES = 8, NTHREADS = 512;
constexpr int LDS_BYTES = 147456;
struct Args { const float* in[19]; float* out; unsigned char* ws; int ph_lo, ph_hi; };

__device__ __forceinline__ void p0_transpose_item(const float* W, int K, int Nsrc, int srccol  , bf16_t* WT, int r0d, const float* ksc, LAS float* scr, int kb, int lane) {
    const int k0 = 64 * kb, nq = lane & 7, kr = lane >> 3;
    f32x4 v[8]; float sc[8];
#pragma unroll
    for (int j = 0; j < 8; ++j) { v[j] = __builtin_nontemporal_load((const f32x4*)(W + (size_t)(k0 + 8 * j + kr) * Nsrc + srccol)); sc[j] = ksc ? ksc[k0 + 8 * j + kr] : 1.0f; }
#pragma unroll
    for (int j = 0; j < 8; ++j) { LAS float* d = scr + (8 * j + kr) * 33 + 4 * nq; d[0] = v[j][0] * sc[j]; d[1] = v[j][1] * sc[j]; d[2] = v[j][2] * sc[j]; d[3] = v[j][3] * sc[j]; }
    asm volatile("s_waitcnt lgkmcnt(0)" ::: "memory");
    const int c = lane & 7;
#pragma unroll
    for (int j = 0; j < 4; ++j) { const int n = (lane >> 3) + 8 * j; const LAS float* s = scr + (8 * c) * 33 + n;
        u32x4 o; o.x = cvt_pk_bf16(s[0 * 33], s[1 * 33]); o.y = cvt_pk_bf16(s[2 * 33], s[3 * 33]); o.z = cvt_pk_bf16(s[4 * 33], s[5 * 33]); o.w = cvt_pk_bf16(s[6 * 33], s[7 * 33]);
        *(u32x4*)(WT + (size_t)(r0d + n) * K + k0 + 8 * c) = o; }
    asm volatile("s_waitcnt lgkmcnt(0)" ::: "memory");
}
__device__ __forceinline__ int w1_src_col(int r) {
    const int pn = r >> 8, j = r & 255;
    if (pn < 8)  return ((j >> 7) ? 2 : 0) * 1024 + 128 * pn + (j & 127);
    if (pn < 24) { const int bj = j >> 7, n = (j >> 2) & 1, wc = (j >> 5) & 3, fq = (j >> 3) & 3; const int sec = bj ? (n ? 6 : 4) : (n ? 5 : 3); return sec * 1024 + 64 * (pn - 8) + 16 * wc + 4 * fq; }
    if (pn < 28) return 1 * 1024 + 256 * (pn - 24) + j;
    if (pn < 32) return 7 * 1024 + 256 * (pn - 28) + j;
    return 8 * 1024 + 256 * (pn - 32) + j;
}

__global__ void __launch_bounds__(NTHREADS, 2) mk_fwd(Args args) {
    extern __shared__ __attribute__((aligned(16))) unsigned char lds_raw[];
    LAS unsigned char* lds = (LAS unsigned char*)lds_raw;
    cg::grid_group grid = cg::this_grid();
    const int tid = threadIdx.x, lane = tid & 63, wave = __builtin_amdgcn_readfirstlane(tid >> 6);
    const int G = gridDim.x, bx = blockIdx.x;
    const int gw = bx * NWAVES + wave, NGW = G * NWAVES;
    unsigned char* ws = args.ws; float* out = args.out;
    const float *x_p = args.in[0], *x_s = args.in[1], *state_conv = args.in[2], *p_p = args.in[3], *p_s = args.in[4], *norm_g = args.in[5], *w_in = args.in[6],
                *ln_g = args.in[7], *ln_b = args.in[8], *w_s = args.in[9], *b_s = args.in[10], *conv_w = args.in[11], *w_a = args.in[12], *w_b = args.in[13], *w_o = args.in[14],
                *pe_g = args.in[15], *w_pg = args.in[16], *w_pp = args.in[17], *fin_g = args.in[18];
    bf16_t *W1 = (bf16_t*)(ws + WS_W1), *W2 = (bf16_t*)(ws + WS_W2), *W3 = (bf16_t*)(ws + WS_W3), *W4 = (bf16_t*)(ws + WS_W4), *W5 = (bf16_t*)(ws + WS_W5), *WS = (bf16_t*)(ws + WS_WS);
    bf16_t* PBIN = (bf16_t*)(ws + WS_PB);
    float* INV = (float*)(ws + WS_INV);
    f32x2* VST = (f32x2*)(ws + WS_VST); float* ST1 = (float*)(ws + WS_ST1); float* ST2 = (float*)(ws + WS_ST2);
    bf16_t *S0 = (bf16_t*)(ws + WS_S0), *S1 = (bf16_t*)(ws + WS_S0 + U), *S2 = (bf16_t*)(ws + WS_S0 + 2 * U), *S3 = (bf16_t*)(ws + WS_S0 + 3 * U), *S4 = (bf16_t*)(ws + WS_S0 + 4 * U), *S5 = (bf16_t*)(ws + WS_S0 + 5 * U);
    bf16_t *XB = S1, *YA = S0, *UG = S2, *YB = S3, *SMB = S4, *VG = S5, *MG = S2, *X1B = S0, *X2B = S4;
    unsigned char *SAq = (unsigned char*)out, *SBq = (unsigned char*)out + (size_t)M * D;
    bf16_t* PBUF = (bf16_t*)((unsigned char*)out + 2 * (size_t)M * D);
    const int lo = args.ph_lo, hi = args.ph_hi;
#define IN(k) (lo <= (k) && (k) < hi)
    if (tid < 16) ((LAS unsigned*)(lds + 131072 + 64))[tid] = 0u;
    __syncthreads();
    const XcdBarrier bar = xcd_barrier_post((unsigned*)(ws + WS_CTL), (volatile LAS unsigned*)(lds + 131072 + 64));
    if (hi > 1000) grid.sync();
#define GRID_BAR() xcd_barrier(bar)
#define SEAM(k) do { if (IN(k) && IN((k) + 1)) { GRID_BAR(); if (MK_REPEAT == 11) GRID_BAR(); } } while (0)

    if (IN(0)) for (int rep = 0; rep < (MK_REPEAT == 0 ? 2 : 1); ++rep) { if (rep) GRID_BAR();
        LAS float* scr = (LAS float*)(lds + wave * 16384);
        constexpr int I1 = 16 * 288, I5 = 4 * 32;
        constexpr int NITEMS = I1 + I5;
        for (int it = gw; it < NITEMS; it += NGW) {
            int r = it;
            if (r < I1) { const int kb = r / 288, nb = r % 288; p0_transpose_item(w_in, 1024, NIN, w1_src_col(nb * 32 + 4 * (lane & 7)), W1, nb * 32, norm_g, scr, kb, lane); continue; } r -= I1;
            p0_transpose_item(w_pp, 256, 1024, (r % 32) * 32 + 4 * (lane & 7), W5, (r % 32) * 32, nullptr, scr, r / 32, lane);
        }
        for (int t = 0; ; ++t) {
            int m0, nr;
            if (G == 256) { if (t < 2) { m0 = 2048 * (bx & 7) + 64 * (bx >> 3) + 8 * wave + 4 * t; nr = 4; } else if (t == 2 && wave == 0) { m0 = NPROMPT + 2 * bx; nr = 2; } else break; }
            else { m0 = 2 * gw + 2 * NGW * t; nr = 2; if (m0 >= M) break; }
            f32x4 v[4][4], pv[4]; float ssum[4];
#pragma unroll
            for (int r = 0; r < 4; ++r) if (r < nr) {
                const int m = m0 + r;
                const float* xr = m < NPROMPT ? x_p + (size_t)m * D : x_s + (size_t)(m - NPROMPT) * D;
                const float* pr = m < NPROMPT ? p_p + (size_t)m * PD : p_s + (size_t)(m - NPROMPT) * PD;
#pragma unroll
                for (int j = 0; j < 4; ++j) v[r][j] = __builtin_nontemporal_load((const f32x4*)(xr + 4 * lane + 256 * j));
                pv[r] = __builtin_nontemporal_load((const f32x4*)(pr + 4 * lane));
            }
#pragma unroll
            for (int r = 0; r < 4; ++r) { float q = 0.f;
                if (r < nr) {
#pragma unroll
                    for (int j = 0; j < 4; ++j) q += (v[r][j][0] * v[r][j][0] + v[r][j][1] * v[r][j][1]) + (v[r][j][2] * v[r][j][2] + v[r][j][3] * v[r][j][3]); }
                ssum[r] = q; }
#pragma unroll
            for (int o = 1; o < 64; o <<= 1) {
#pragma unroll
                for (int r = 0; r < 4; ++r) ssum[r] += __shfl_xor(ssum[r], o); }
#pragma unroll
            for (int r = 0; r < 4; ++r) if (r < nr) {
                const int m = m0 + r; const float rstd = __builtin_amdgcn_rsqf(ssum[r] * (1.0f / D) + EPS);
                if (lane == 0) INV[m] = __builtin_amdgcn_rcpf(rstd);
#pragma unroll
                for (int j = 0; j < 4; ++j) *(u32x2*)(XB + (size_t)m * D + 4 * lane + 256 * j) = (u32x2){cvt_pk_bf16(v[r][j][0] * rstd, v[r][j][1] * rstd), cvt_pk_bf16(v[r][j][2] * rstd, v[r][j][3] * rstd)};
                *(u32x2*)(PBIN + (size_t)m * PD + 4 * lane) = (u32x2){cvt_pk_bf16(pv[r][0], pv[r][1]), cvt_pk_bf16(pv[r][2], pv[r][3])};
            }
        }
    }
    SEAM(0);
    if (MK_REPEAT == 8) { GRID_BAR(); GRID_BAR(); GRID_BAR(); GRID_BAR(); }

    if (IN(1)) {
        for (int rep = 0; rep < (MK_REPEAT == 1 ? 2 : 1); ++rep) {
        pg8::Gemm g{XB, W1, M, NIN, D}; pg8::P1Order S; S.init(G, bx);
        Epi1 E{UG, VG, SMB, SAq, VST, out, conv_w};
        pg8::gemm_phase<Epi1, pg8::P1Order, true, true>(lds, g, S, E); }
        { pg8::Gemm g2{PBIN, W5, NPROMPT, D, PD}; pg8::SlackOrder S2; S2.init(G, bx, ((M / 256) * (NIN / 256)) % G);
          EpiP E2{PBUF};
          pg8::gemm_phase<EpiP, pg8::SlackOrder, true, true>(lds, g2, S2, E2); }
        {
            const int first = ((M / 256) * (NIN / 256)) % G, ns = (first > 0 ? G - first : G), c2 = (first > 0 ? bx - first : bx);
            LAS float* scr = (LAS float*)(lds + wave * 16384);
            constexpr int I2 = 16 * 32;
            if (c2 >= 0) for (int it = c2 * NWAVES + wave; it < 4 * I2 + 256; it += ns * NWAVES) {
                int r = it;
                if (r < I2) { p0_transpose_item(w_a, 1024, 1024, (r % 32) * 32 + 4 * (lane & 7), W2, (r % 32) * 32, nullptr, scr, r / 32, lane); continue; } r -= I2;
                if (r < I2) { p0_transpose_item(w_b, 1024, 1024, (r % 32) * 32 + 4 * (lane & 7), W2, 1024 + (r % 32) * 32, nullptr, scr, r / 32, lane); continue; } r -= I2;
                if (r < I2) { p0_transpose_item(w_o, 1024, 1024, (r % 32) * 32 + 4 * (lane & 7), W3, (r % 32) * 32, nullptr, scr, r / 32, lane); continue; } r -= I2;
                if (r < I2) { p0_transpose_item(w_pg, 1024, 1024, (r % 32) * 32 + 4 * (lane & 7), W4, (r % 32) * 32, pe_g, scr, r / 32, lane); continue; } r -= I2;
                const int e0 = r * 512 + lane * 8; const int s0 = e0 & 127, t = (e0 >> 7) & 127;
                const f32x4 a = *(const f32x4*)(w_s + e0), b = *(const f32x4*)(w_s + e0 + 4);
                float v[8] = {a[0], a[1], a[2], a[3], b[0], b[1], b[2], b[3]};
#pragma unroll
                for (int i = 0; i < 8; ++i) if (s0 + i > t) v[i] = 0.f;
                *(u32x4*)(WS + e0) = PACK8(v);
            }
        }
    }
    SEAM(1);

    if (IN(2)) for (int rep = 0; rep < (MK_REPEAT == 2 ? 2 : 1); ++rep) { if (rep) GRID_BAR();
        constexpr int NMIX = 512;
        LAS float* ST2L = (LAS float*)(lds + 67584);
        LAS float* ST = ST2L;
        for (int it = 0; ; ++it) {
            int unit;
            if (G == 256) { const int xq = bx & 7, jq = bx >> 3;
                if (it < 2) unit = 64 * xq + jq + 32 * it; else if (it == 2) unit = NMIX + 128 + 32 * xq + jq; else if (it == 3 && bx < 128) unit = NMIX + bx; else break; }
            else { unit = bx + it * G; if (unit >= NMIX + 128 + 256) break; }
            if (unit >= NMIX + 128) {
                const int k = unit - (NMIX + 128), rr = tid >> 8, col = 4 * (tid & 255);
                const bool hist = ((k * 64) & 2047) != 0;
                const u32x2 bgw = *(const u32x2*)(SMB + SM_BGF + (size_t)(k * 2 + rr) * 1024 + col);
                const u32x2 cf0 = *(const u32x2*)(SMB + SM_CHF + (size_t)(k * 2 + 0) * 1024 + col), cf1 = *(const u32x2*)(SMB + SM_CHF + (size_t)(k * 2 + 1) * 1024 + col);
                u32x2 cl0 = (u32x2){0u, 0u}, cl1 = (u32x2){0u, 0u};
                if (hist) { cl0 = *(const u32x2*)(SMB + SM_CHL + (size_t)((k - 1) * 2 + 0) * 1024 + col); cl1 = *(const u32x2*)(SMB + SM_CHL + (size_t)((k - 1) * 2 + 1) * 1024 + col); }
                const f32x4 w0 = *(const f32x4*)(conv_w + col), w1 = *(const f32x4*)(conv_w + 1024 + col), w2 = *(const f32x4*)(conv_w + 2048 + col);
                const u32x2 a2 = rr ? cl1 : cl0, a1 = rr ? cf0 : cl1, a0 = rr ? cf1 : cf0;
                f32x4 y;
                y[0] = bflo(bgw[0]) * (w0[0] * bflo(a2[0]) + w1[0] * bflo(a1[0]) + w2[0] * bflo(a0[0])); y[1] = bfhi(bgw[0]) * (w0[1] * bfhi(a2[0]) + w1[1] * bfhi(a1[0]) + w2[1] * bfhi(a0[0]));
                y[2] = bflo(bgw[1]) * (w0[2] * bflo(a2[1]) + w1[2] * bflo(a1[1]) + w2[2] * bflo(a0[1])); y[3] = bfhi(bgw[1]) * (w0[3] * bfhi(a2[1]) + w1[3] * bfhi(a1[1]) + w2[3] * bfhi(a0[1]));
                *(u32x2*)(YB + (size_t)(k * 64 + rr) * 1024 + col) = (u32x2){cvt_pk_bf16(y[0], y[1]), cvt_pk_bf16(y[2], y[3])};
            } else if (unit < NMIX) {
                const int c = unit >> 2, hp = unit & 3, R0 = c * 128;
                const int cch = tid & 31, rg = tid >> 5, dch = hp * 256 + cch * 8;
                const int hh = wave >> 2, tb = wave & 3, fr = lane & 15, g4 = lane >> 4;
                const int h = hp * 2 + hh;
                f32x2 stv[4];
#pragma unroll
                for (int j = 0; j < 4; ++j) stv[j] = VST[(size_t)(R0 + (tid >> 2)) * 16 + 4 * (tid & 3) + j];
                u32x4 vw[8];
#pragma unroll
                for (int j = 0; j < 8; ++j) vw[j] = __builtin_nontemporal_load((const u32x4*)(VG + (size_t)(R0 + rg + 16 * j) * 1024 + dch));
                const f32x4 g0 = *(const f32x4*)(ln_g + dch), g1 = *(const f32x4*)(ln_g + dch + 4), b0 = *(const f32x4*)(ln_b + dch), b1 = *(const f32x4*)(ln_b + dch + 4);
                const bf16_t* Wh = WS + (size_t)h * 16384;
                u32x2 bWl[4][2], bWh[4][2];
#pragma unroll
                for (int ks = 0; ks < 4; ++ks)
                    if (ks <= tb) {
#pragma unroll
                        for (int n = 0; n < 2; ++n) { const bf16_t* wp = Wh + (size_t)(32 * tb + 16 * n + fr) * 128 + 32 * ks + 4 * g4; bWl[ks][n] = *(const u32x2*)wp; bWh[ks][n] = *(const u32x2*)(wp + 16); }
                    }
                {
                    float s = (stv[0][0] + stv[1][0]) + (stv[2][0] + stv[3][0]), ss = (stv[0][1] + stv[1][1]) + (stv[2][1] + stv[3][1]);
                    s += __shfl_xor(s, 1); ss += __shfl_xor(ss, 1); s += __shfl_xor(s, 2); ss += __shfl_xor(ss, 2);
                    const float mean = s * (1.0f / 1024.0f), var = fmaxf(ss * (1.0f / 1024.0f) - mean * mean, 0.f);
                    if ((tid & 3) == 0) { ST2L[2 * (tid >> 2)] = mean; ST2L[2 * (tid >> 2) + 1] = __builtin_amdgcn_rsqf(var + LN_EPS); }
                }
                __syncthreads();
                u32x4 uw[2][4]; float bsv[2];
#pragma unroll
                for (int n = 0; n < 2; ++n) {
                    const int t = 32 * tb + 16 * n + fr; bsv[n] = b_s[h * 128 + t];
                    const size_t off = (size_t)(R0 + t) * 1024 + h * 128 + 32 * g4;
#pragma unroll
                    for (int k = 0; k < 4; ++k) uw[n][k] = __builtin_nontemporal_load((const u32x4*)(UG + off + 8 * k));
                }
                {
                    const bool lastc = (c & 15) == 15; const int bidx = c >> 4;
                    LAS unsigned char* img = lds + (cch >> 4) * 33792 + (cch & 15) * 16;
#pragma unroll
                    for (int j = 0; j < 8; ++j) {
                        const int sI = rg + 16 * j; float v[8]; UNPACK8(vw[j], v);
                        const float mean = ST2L[2 * sI], rstd = ST2L[2 * sI + 1];
#pragma unroll
                        for (int i = 0; i < 4; ++i) { v[i] = (v[i] - mean) * rstd * g0[i] + b0[i]; v[4 + i] = (v[4 + i] - mean) * rstd * g1[i] + b1[i]; }
                        if (lastc) { float* o = out + O_VP + (size_t)(bidx * 128 + sI) * 1024 + dch; *(f32x4*)o = (f32x4){v[0], v[1], v[2], v[3]}; *(f32x4*)(o + 4) = (f32x4){v[4], v[5], v[6], v[7]}; }
                        *(LAS u32x2*)(img + sI * 264) = (u32x2){cvt_pk_bf16(v[0], v[1]), cvt_pk_bf16(v[2], v[3])};
                        *(LAS u32x2*)(img + sI * 264 + 8) = (u32x2){cvt_pk_bf16(v[4], v[5]), cvt_pk_bf16(v[6], v[7])};
                    }
                }
                __syncthreads();
                {
                    f32x4 acc[8][2];
#pragma unroll
                    for (int a2 = 0; a2 < 8; ++a2)
#pragma unroll
                        for (int b2 = 0; b2 < 2; ++b2) acc[a2][b2] = (f32x4){0.f, 0.f, 0.f, 0.f};
                    const LAS unsigned char* tra = lds + hh * 33792 + (4 * g4 + ((lane & 15) >> 2)) * 264 + (lane & 3) * 64;
#pragma unroll
                    for (int ks = 0; ks < 4; ++ks)
                        if (ks <= tb) {
                            bf16x8 bW[2];
#pragma unroll
                            for (int n = 0; n < 2; ++n) bW[n] = __builtin_bit_cast(bf16x8, (u32x4){bWl[ks][n][0], bWl[ks][n][1], bWh[ks][n][0], bWh[ks][n][1]});
#pragma unroll
                            for (int d = 0; d < 8; ++d) {
                                const v4i16_t lo = __builtin_amdgcn_ds_read_tr16_b64_v4i16((LAS v4i16_t*)(tra + (32 * ks) * 264 + 8 * d));
                                const v4i16_t hi2 = __builtin_amdgcn_ds_read_tr16_b64_v4i16((LAS v4i16_t*)(tra + (32 * ks + 16) * 264 + 8 * d));
                                const bf16x8 aV = (bf16x8){lo[0], lo[1], lo[2], lo[3], hi2[0], hi2[1], hi2[2], hi2[3]};
#pragma unroll
                                for (int n = 0; n < 2; ++n) acc[d][n] = __builtin_amdgcn_mfma_f32_16x16x32_bf16(aV, bW[n], acc[d][n], 0, 0, 0);
                            }
                        }
#pragma unroll
                    for (int n = 0; n < 2; ++n) {
                        const int t = 32 * tb + 16 * n + fr;
                        const size_t off = (size_t)(R0 + t) * 1024 + h * 128 + 32 * g4;
#pragma unroll
                        for (int k = 0; k < 4; ++k) {
                            float ug[8], o[8]; UNPACK8(uw[n][k], ug);
#pragma unroll
                            for (int i = 0; i < 4; ++i) { o[i] = ug[i] * (acc[2 * k][n][i] + bsv[n]); o[4 + i] = ug[4 + i] * (acc[2 * k + 1][n][i] + bsv[n]); }
                            *(u32x4*)(YA + off + 8 * k) = PACK8(o);
                        }
                    }
                }
                __syncthreads();
            } else {
                const int b = unit - NMIX, R0 = NPROMPT + 4 * b;
                if (tid < 4) {
                    const f32x2* vs = VST + (size_t)(R0 + tid) * 16; float s = 0.f, ss = 0.f;
#pragma unroll
                    for (int j = 0; j < 16; ++j) { const f32x2 v = vs[j]; s += v[0]; ss += v[1]; }
                    const float mean = s * (1.0f / 1024.0f), var = fmaxf(ss * (1.0f / 1024.0f) - mean * mean, 0.f);
                    ST[2 * tid] = mean; ST[2 * tid + 1] = __builtin_amdgcn_rsqf(var + LN_EPS);
                }
                __syncthreads();
                {
                    const int ch = 2 * tid, h = ch >> 7;
                    const f32x2 g2 = *(const f32x2*)(ln_g + ch), b2 = *(const f32x2*)(ln_b + ch);
                    float vn[4][2];
#pragma unroll
                    for (int t = 0; t < 4; ++t) {
                        const unsigned w = *(const unsigned*)(VG + (size_t)(R0 + t) * 1024 + ch);
                        const float mean = ST[2 * t], rstd = ST[2 * t + 1];
                        vn[t][0] = (bflo(w) - mean) * rstd * g2[0] + b2[0]; vn[t][1] = (bfhi(w) - mean) * rstd * g2[1] + b2[1];
                        *(f32x2*)(out + O_VS + (size_t)(b * 4 + t) * 1024 + ch) = (f32x2){vn[t][0], vn[t][1]};
                    }
                    const f32x2 c0 = *(const f32x2*)(conv_w + ch), c1 = *(const f32x2*)(conv_w + 1024 + ch), c2 = *(const f32x2*)(conv_w + 2048 + ch);
                    f32x2 q2 = *(const f32x2*)(state_conv + (size_t)(b * 2 + 0) * 1024 + ch), q1 = *(const f32x2*)(state_conv + (size_t)(b * 2 + 1) * 1024 + ch);
#pragma unroll
                    for (int t = 0; t < 4; ++t) {
                        const size_t off = (size_t)(R0 + t) * 1024 + ch;
                        float s0 = b_s[h * 128 + t], s1 = s0;
#pragma unroll
                        for (int s = 0; s <= t; ++s) { const float wv = w_s[(size_t)h * 16384 + t * 128 + s]; s0 += wv * vn[s][0]; s1 += wv * vn[s][1]; }
                        const size_t so = (size_t)(4 * b + t) * 1024 + ch;
                        const unsigned uw = *(const unsigned*)(UG + off), cw = *(const unsigned*)(SMB + SM_CHS + so), bw = *(const unsigned*)(SMB + SM_BGS + so);
                        *(unsigned*)(YA + off) = cvt_pk_bf16(bflo(uw) * s0, bfhi(uw) * s1);
                        const f32x2 cu = (f32x2){bflo(cw), bfhi(cw)};
                        *(unsigned*)(YB + off) = cvt_pk_bf16(bflo(bw) * (c0[0] * q2[0] + c1[0] * q1[0] + c2[0] * cu[0]), bfhi(bw) * (c0[1] * q2[1] + c1[1] * q1[1] + c2[1] * cu[1]));
                        q2 = q1; q1 = cu;
                    }
                }
                __syncthreads();
            }
        }
    }
    SEAM(2);

    if (IN(3)) {
        for (int rep = 0; rep < (MK_REPEAT == 3 ? 2 : 1); ++rep)
        { pg8::Gemm g{YA, W2, NPROMPT, D, D}; pg8::PairOrder S; S.init(NPROMPT, D, G, bx, 3 * M);
          Epi2 E{SAq, SBq, MG};
          pg8::gemm_phase<Epi2, pg8::PairOrder, true, true>(lds, g, S, E); }
        for (int c = bx; c < 256; c += G) {
            const int r0 = NPROMPT + 32 * (c >> 4), c0 = 64 * (c & 15);
            const f32x4 pa = thin_gemm_s(lds, YA + (size_t)r0 * D, W2 + (size_t)c0 * D, wave, lane, tid);
            const f32x4 pb = thin_gemm_s(lds, YB + (size_t)r0 * D, W2 + (size_t)(1024 + c0) * D, wave, lane, tid);
            const size_t off = (size_t)(r0 + (tid >> 4)) * D + c0 + 4 * (tid & 15);
            const unsigned wa = *(const unsigned*)(SAq + off), wb = *(const unsigned*)(SBq + off); const float k = 1.0f / 255.0f;
            *(u32x2*)(MG + off) = (u32x2){cvt_pk_bf16(((float)(wa & 255u) * pa[0] + (float)(wb & 255u) * pb[0]) * k, ((float)((wa >> 8) & 255u) * pa[1] + (float)((wb >> 8) & 255u) * pb[1]) * k),
                                          cvt_pk_bf16(((float)((wa >> 16) & 255u) * pa[2] + (float)((wb >> 16) & 255u) * pb[2]) * k, ((float)(wa >> 24) * pa[3] + (float)(wb >> 24) * pb[3]) * k)};
        }
    }
    SEAM(3);

    if (IN(4)) for (int rep = 0; rep < (MK_REPEAT == 4 ? 2 : 1); ++rep) { if (rep) GRID_BAR();
        { pg8::Gemm g{MG, W3, NPROMPT, D, D}; pg8::StaticOrder S; S.init(NPROMPT, D, G, bx);
          Epi3 E{XB, INV, X1B, ST1};
          pg8::gemm_phase<Epi3, pg8::StaticOrder, true, true>(lds, g, S, E); }
        for (int c = bx; c < 256; c += G) {
            const int r0 = NPROMPT + 32 * (c >> 4), c0 = 64 * (c & 15), row = r0 + (tid >> 4), col = c0 + 4 * (tid & 15);
            const f32x4 xv = *(const f32x4*)(x_s + (size_t)(row - NPROMPT) * D + col);
            const f32x4 v = xv + thin_gemm_s(lds, MG + (size_t)r0 * D, W3 + (size_t)c0 * D, wave, lane, tid);
            *(u32x2*)(X1B + (size_t)row * D + col) = (u32x2){cvt_pk_bf16(v[0], v[1]), cvt_pk_bf16(v[2], v[3])};
            float ss = (v[0] * v[0] + v[1] * v[1]) + (v[2] * v[2] + v[3] * v[3]);
            ss += __shfl_xor(ss, 1); ss += __shfl_xor(ss, 2); ss += __shfl_xor(ss, 4); ss += __shfl_xor(ss, 8);
            if ((tid & 15) == 0) ST1[(size_t)row * 16 + (c & 15)] = ss;
        }
    }
    SEAM(4);

    if (IN(5)) for (int rep = 0; rep < (MK_REPEAT == 5 ? 2 : 1); ++rep) { if (rep) GRID_BAR();
        { pg8::Gemm g{X1B, W4, NPROMPT, D, D}; pg8::StaticOrder S; S.init(NPROMPT, D, G, bx);
          Epi4 E{X1B, PBUF, ST1, X2B, ST2};
          pg8::gemm_phase<Epi4, pg8::StaticOrder, true, true>(lds, g, S, E); }
        for (int c = bx; c < 256; c += G) {
            const int r0 = NPROMPT + 32 * (c >> 4), c0 = 64 * (c & 15), row = r0 + (tid >> 4), col = c0 + 4 * (tid & 15);
            const u32x2 xw = *(const u32x2*)(X1B + (size_t)row * D + col);
            float s1 = ST1[(size_t)row * 16 + (tid & 15)];
            s1 += __shfl_xor(s1, 1); s1 += __shfl_xor(s1, 2); s1 += __shfl_xor(s1, 4); s1 += __shfl_xor(s1, 8);
            const float rstd = __builtin_amdgcn_rsqf(s1 * (1.0f / 1024.0f) + EPS);
            const f32x4 gq = thin_gemm_s(lds, X1B + (size_t)r0 * D, W4 + (size_t)c0 * D, wave, lane, tid);
            const f32x4 pq = thin_gemm<256>(lds, PBIN + (size_t)r0 * PD, W5 + (size_t)c0 * PD, wave, lane, tid);
            f32x4 v;
            v[0] = bflo(xw[0]) + fsigmoid(rstd * gq[0]) * pq[0]; v[1] = bfhi(xw[0]) + fsigmoid(rstd * gq[1]) * pq[1];
            v[2] = bflo(xw[1]) + fsigmoid(rstd * gq[2]) * pq[2]; v[3] = bfhi(xw[1]) + fsigmoid(rstd * gq[3]) * pq[3];
            *(u32x2*)(X2B + (size_t)row * D + col) = (u32x2){cvt_pk_bf16(v[0], v[1]), cvt_pk_bf16(v[2], v[3])};
            float ss = (v[0] * v[0] + v[1] * v[1]) + (v[2] * v[2] + v[3] * v[3]);
            ss += __shfl_xor(ss, 1); ss += __shfl_xor(ss, 2); ss += __shfl_xor(ss, 4); ss += __shfl_xor(ss, 8);
            if ((tid & 15) == 0) ST2[(size_t)row * 16 + (c & 15)] = ss;
        }
    }
    SEAM(5);

    if (IN(6)) {
        f32x4 gv[4];
#pragma unroll
        for (int j = 0; j < 4; ++j) gv[j] = *(const f32x4*)(fin_g + 4 * lane + 256 * j);
        if (G == 256) {
            const int mb = 2048 * (bx & 7) + 64 * (bx >> 3) + 8 * wave;
            u32x2 xw[8][4]; float p[8];
#pragma unroll
            for (int r = 0; r < 8; ++r) {
#pragma unroll
                for (int j = 0; j < 4; ++j) xw[r][j] = __builtin_nontemporal_load((const u32x2*)(X2B + (size_t)(mb + r) * D + 4 * lane + 256 * j));
                p[r] = lane < 16 ? ST2[(size_t)(mb + r) * 16 + lane] : 0.f;
            }
#pragma unroll
            for (int o = 1; o < 16; o <<= 1) {
#pragma unroll
                for (int r = 0; r < 8; ++r) p[r] += __shfl_xor(p[r], o);
            }
#pragma unroll
            for (int r = 0; r < 8; ++r) {
                const float rstd = __builtin_amdgcn_rsqf(__shfl(p[r], 0) * (1.0f / D) + EPS);
                float* xr = out + (size_t)(mb + r) * D;
#pragma unroll
                for (int j = 0; j < 4; ++j) __builtin_nontemporal_store((f32x4){bflo(xw[r][j][0]), bfhi(xw[r][j][0]), bflo(xw[r][j][1]), bfhi(xw[r][j][1])} * rstd * gv[j], (f32x4*)(xr + 4 * lane + 256 * j));
            }
        }
        for (int t = (G == 256 ? 4 : 0); ; ++t) {
            int m0;
            if (G == 256) { if (t == 4 && wave == 0) m0 = NPROMPT + 2 * bx; else break; }
            else { m0 = 2 * gw + 2 * NGW * t; if (m0 >= M) break; }
            u32x2 xw[2][4]; float p[2];
#pragma unroll
            for (int r = 0; r < 2; ++r) {
#pragma unroll
                for (int j = 0; j < 4; ++j) xw[r][j] = __builtin_nontemporal_load((const u32x2*)(X2B + (size_t)(m0 + r) * D + 4 * lane + 256 * j));
                p[r] = lane < 16 ? ST2[(size_t)(m0 + r) * 16 + lane] : 0.f;
            }
#pragma unroll
            for (int o = 1; o < 16; o <<= 1) { p[0] += __shfl_xor(p[0], o); p[1] += __shfl_xor(p[1], o); }
#pragma unroll
            for (int r = 0; r < 2; ++r) {
                const float rstd = __builtin_amdgcn_rsqf(__shfl(p[r], 0) * (1.0f / D) + EPS);
                float* xr = out + (size_t)(m0 + r) * D;
#pragma unroll
                for (int j = 0; j < 4; ++j) __builtin_nontemporal_store((f32x4){bflo(xw[r][j][0]), bfhi(xw[r][j][0]), bflo(xw[r][j][1]), bfhi(xw[r][j][1])} * rstd * gv[j], (f32x4*)(xr + 4 * lane + 256 * j));
            }
        }
    }
    if (MK_REPEAT == 107 && IN(7)) {
        pg8::Gemm g{XB, W1, M, NIN, D}; pg8::StaticOrder S; S.init(M, NIN, G, bx);
        EpiRaw E{S0};
        pg8::gemm_phase<EpiRaw, pg8::StaticOrder, true, true>(lds, g, S, E);
    }
#undef IN
#undef SEAM
}

extern "C" void kernel_launch(void* const* d_in, const int* in_sizes, int n_in, void* d_out, int out_size, void* d_ws, size_t ws_size, hipStream_t stream) {
    static int grid = 0;
    if (grid == 0) {
        if (n_in != 19 || ws_size < WS_END) { fprintf(stderr, "kernel_launch: unexpected problem (n_in %d, ws %zu < %zu)\n", n_in, ws_size, (size_t)WS_END); grid = -1; return; }
        int dev = 0, cus = 0, per_cu = 0;
        (void)hipGetDevice(&dev);
        (void)hipDeviceGetAttribute(&cus, hipDeviceAttributeMultiprocessorCount, dev);
        if (hipFuncSetAttribute((const void*)mk_fwd, hipFuncAttributeMaxDynamicSharedMemorySize, LDS_BYTES) != hipSuccess) { fprintf(stderr, "kernel_launch: hipFuncSetAttribute failed\n"); grid = -1; return; }
        if (hipOccupancyMaxActiveBlocksPerMultiprocessor(&per_cu, (const void*)mk_fwd, NTHREADS, LDS_BYTES) != hipSuccess || per_cu < 1) { fprintf(stderr, "kernel_launch: occupancy query says %d\n", per_cu); per_cu = 1; }
        (void)hipGetLastError();
        grid = cus * per_cu;
        if (grid <= 0) grid = 256;
    }
    if (grid < 0) return;
    (void)hipMemsetAsync((unsigned char*)d_ws + WS_CTL, 0, CTL_BYTES, stream);
    if (MK_REPEAT == 12) { (void)hipMemsetAsync((unsigned char*)d_ws + WS_CTL, 0, CTL_BYTES, stream); (void)hipMemsetAsync((unsigned char*)d_ws + WS_CTL, 0, CTL_BYTES, stream); }
    Args a{};
    for (int i = 0; i < 19; ++i) a.in[i] = (const float*)d_in[i];
    a.out = (float*)d_out; a.ws = (unsigned char*)d_ws;
#if MK_N_LAUNCHES == 1
    a.ph_lo = 0; a.ph_hi = 7;
    { void* kargs[] = {&a};
      if (MK_REPEAT == 9) { (void)hipLaunchCooperativeKernel((const void*)mk_fwd, dim3(grid), dim3(NTHREADS), kargs, LDS_BYTES, stream);
                            (void)hipMemsetAsync((unsigned char*)d_ws + WS_CTL, 0, CTL_BYTES, stream); }
      if (MK_REPEAT == 10) { Args e0 = a; e0.ph_lo = 0; e0.ph_hi = 0; void* k0[] = {&e0};
                            (void)hipLaunchCooperativeKernel((const void*)mk_fwd, dim3(grid), dim3(NTHREADS), k0, LDS_BYTES, stream);
                            (void)hipMemsetAsync((unsigned char*)d_ws + WS_CTL, 0, CTL_BYTES, stream); }
      hipError_t e = hipLaunchCooperativeKernel((const void*)mk_fwd, dim3(grid), dim3(NTHREADS), kargs, LDS_BYTES, stream);
      if (e != hipSuccess) fprintf(stderr, "cooperative launch failed: %s (grid %d)\n", hipGetErrorString(e), grid);
      if (MK_REPEAT >= 100) {
          Args e1 = a; e1.ph_lo = MK_REPEAT - 100; e1.ph_hi = MK_REPEAT - 99; void* k1[] = {&e1};
          (void)hipMemsetAsync((unsigned char*)d_ws + WS_CTL, 0, CTL_BYTES, stream);
          (void)hipLaunchCooperativeKernel((const void*)mk_fwd, dim3(grid), dim3(NTHREADS), k1, LDS_BYTES, stream);
          if (MK_REPEAT == 101) { Args e2 = a; e2.ph_lo = 6; e2.ph_hi = 7; void* k2[] = {&e2};
              (void)hipMemsetAsync((unsigned char*)d_ws + WS_CTL, 0, CTL_BYTES, stream);
              (void)hipLaunchCooperativeKernel((const void*)mk_fwd, dim3(grid), dim3(NTHREADS), k2, LDS_BYTES, stream); }
      } }
#else
    for (int ph = 0; ph < 7; ++ph) {
        a.ph_lo = ph; a.ph_hi = ph + 1;
        hipLaunchKernelGGL(mk_fwd, dim3(grid), dim3(NTHREADS), LDS_BYTES, stream, a);
    }
#endif
}
```
